# Optimizing an MI355X kernel written in HIP

```python
import math, functools
import jax, jax.numpy as jnp
from jax import lax
import numpy as np

D_MODEL = 1024
BATCH = 4
SEQ = 4096
DEPTH = 1
DEC_BATCH = 128
DEC_SEQ = 8
PAST_LEN = 8192
PAGE_SIZE = 128

N_META = 16
MIX_W = D_MODEL
S5_W = MIX_W // 2
S5_GROUP = 16
S5_GROUPS = S5_W // S5_GROUP
S5_STATE = 64
MLA_HEADS = 4
QK_NOPE = 128
QK_ROPE = 64
V_HEAD = 128
Q_RANK = 384
KV_RANK = 256
D_FF = 256 * ((8 * D_MODEL // 3 + 255) // 256)
CONV_W = 3
ROPE_BASE = 10000.0
Q_BLOCK = 128
EPS = 1e-6
IN_W = S5_W + Q_RANK + KV_RANK + QK_ROPE
ATTN_SCALE = 1.0 / math.sqrt(QK_NOPE + QK_ROPE)
N_PAGES = PAST_LEN // PAGE_SIZE
N_POOL = (DEC_BATCH * N_PAGES * 5) // 4

kernel_name = "hymba_s5_mla_convffn_step"

F32 = jnp.float32


def rmsnorm(x, g):
    x32 = x.astype(F32)
    y = x32 * lax.rsqrt(jnp.mean(x32 * x32, axis=-1, keepdims=True) + EPS)
    return (y * g.astype(F32)).astype(x.dtype)


def rope(x, pos):
    half = QK_ROPE // 2
    inv = ROPE_BASE ** (-jnp.arange(half, dtype=F32) / half)
    ang = pos.astype(F32)[:, None] * inv[None, :]
    ang = ang.reshape(ang.shape[:1] + (1,) * (x.ndim - 3) + (half,))
    cos, sin = jnp.cos(ang), jnp.sin(ang)
    x32 = x.astype(F32)
    x1, x2 = x32[..., :half], x32[..., half:]
    return jnp.concatenate([x1 * cos - x2 * sin, x1 * sin + x2 * cos], axis=-1).astype(x.dtype)


def project_mixers(xn, pos, lw):
    z = xn @ lw["w_in"]
    u, c_q, c_kv, k_r = jnp.split(z, [S5_W, S5_W + Q_RANK, S5_W + Q_RANK + KV_RANK], axis=-1)
    b, t = xn.shape[:2]
    q = (rmsnorm(c_q, lw["g_q"]) @ lw["w_uq"]).reshape(b, t, MLA_HEADS, QK_NOPE + QK_ROPE)
    q_lat = jnp.einsum("bthn,rhn->bthr", q[..., :QK_NOPE], lw["w_uk"])
    q_rope = rope(q[..., QK_NOPE:], pos)
    ckv = rmsnorm(c_kv, lw["g_kv"])
    kr = rope(k_r, pos)
    return u, q_lat, q_rope, ckv, kr


def s5_discretise(a_re, a_im, log_dt, b_re, b_im):
    dt = jnp.exp(log_dt.astype(F32))[:, None]
    ar, ai = a_re.astype(F32), a_im.astype(F32)
    mag = jnp.exp(dt * ar)
    abar_re, abar_im = mag * jnp.cos(dt * ai), mag * jnp.sin(dt * ai)
    num_re, num_im = abar_re - 1.0, abar_im
    den = ar * ar + ai * ai
    f_re = (num_re * ar + num_im * ai) / den
    f_im = (num_im * ar - num_re * ai) / den
    br, bi = b_re.astype(F32), b_im.astype(F32)
    bbar_re = f_re[..., None] * br - f_im[..., None] * bi
    bbar_im = f_re[..., None] * bi + f_im[..., None] * br
    return abar_re, abar_im, bbar_re, bbar_im


def _ssm_combine(e1, e2):
    a1r, a1i, b1r, b1i = e1
    a2r, a2i, b2r, b2i = e2
    return (a2r * a1r - a2i * a1i,
            a2r * a1i + a2i * a1r,
            a2r * b1r - a2i * b1i + b2r,
            a2r * b1i + a2i * b1r + b2i)


def s5_mixer(u, h0_re, h0_im, lw):
    b, t, _ = u.shape
    u32 = u.astype(F32)
    ug = u32.reshape(b, t, S5_GROUPS, S5_GROUP)
    abr, abi, bbr, bbi = s5_discretise(lw["s5_a_re"], lw["s5_a_im"], lw["s5_log_dt"], lw["s5_b_re"], lw["s5_b_im"])
    bu_re = jnp.einsum("btgh,gph->tbgp", ug, bbr)
    bu_im = jnp.einsum("btgh,gph->tbgp", ug, bbi)
    h0r, h0i = h0_re.astype(F32), h0_im.astype(F32)
    bu_re = bu_re.at[0].add(abr * h0r - abi * h0i)
    bu_im = bu_im.at[0].add(abr * h0i + abi * h0r)
    a_re = jnp.broadcast_to(abr, (t, 1) + abr.shape)
    a_im = jnp.broadcast_to(abi, (t, 1) + abi.shape)
    _, _, h_re, h_im = lax.associative_scan(_ssm_combine, (a_re, a_im, bu_re, bu_im), axis=0)
    y = (jnp.einsum("tbgp,ghp->btgh", h_re, lw["s5_c_re"].astype(F32))
         - jnp.einsum("tbgp,ghp->btgh", h_im, lw["s5_c_im"].astype(F32)))
    y = y.reshape(b, t, S5_W) + lw["s5_d"].astype(F32) * u32
    y = jax.nn.gelu(y)
    y = y * jax.nn.sigmoid(y @ lw["w_glu"].astype(F32))
    return y.astype(u.dtype), h_re[-1], h_im[-1]


def attend(q_lat, q_rope, q_pos, ckv, kr, k_pos):
    s = (jnp.einsum("bqhr,bkr->bhqk", q_lat, ckv).astype(F32)
         + jnp.einsum("bqhe,bke->bhqk", q_rope, kr).astype(F32)) * ATTN_SCALE
    s = jnp.where(k_pos[None, :] <= q_pos[:, None], s, -jnp.inf)
    p = jax.nn.softmax(s, axis=-1).astype(ckv.dtype)
    return jnp.einsum("bhqk,bkr->bqhr", p, ckv)


def prompt_attention(q_lat, q_rope, ckv, kr, pos):
    b = q_lat.shape[0]
    o_meta = attend(q_lat[:, :N_META], q_rope[:, :N_META], pos[:N_META], ckv, kr, pos)
    nb = (q_lat.shape[1] - N_META) // Q_BLOCK

    def blocks(a):
        return a[:, N_META:].reshape((b, nb, Q_BLOCK) + a.shape[2:]).swapaxes(0, 1)

    def one(args):
        ql, qr, qp = args
        return attend(ql, qr, qp, ckv, kr, pos)

    o = lax.map(one, (blocks(q_lat), blocks(q_rope), pos[N_META:].reshape(nb, Q_BLOCK)))
    o = o.swapaxes(0, 1).reshape((b, nb * Q_BLOCK) + o.shape[3:])
    return jnp.concatenate([o_meta, o], axis=1)


def sample_attention(q_lat, q_rope, ckv, kr, pos, past_ckv, past_kr):
    n_past = past_ckv.shape[1]
    s_past = (jnp.einsum("bqhr,bkr->bhqk", q_lat, past_ckv).astype(F32)
              + jnp.einsum("bqhe,bke->bhqk", q_rope, past_kr).astype(F32)) * ATTN_SCALE
    s_new = (jnp.einsum("bqhr,bkr->bhqk", q_lat, ckv).astype(F32)
             + jnp.einsum("bqhe,bke->bhqk", q_rope, kr).astype(F32)) * ATTN_SCALE
    s_new = jnp.where(pos[None, :] <= pos[:, None], s_new, -jnp.inf)
    p = jax.nn.softmax(jnp.concatenate([s_past, s_new], axis=-1), axis=-1).astype(ckv.dtype)
    return (jnp.einsum("bhqk,bkr->bqhr", p[..., :n_past], past_ckv)
            + jnp.einsum("bhqk,bkr->bqhr", p[..., n_past:], ckv))


def conv_ffn(xn, conv_prev, lw):
    gate = xn @ lw["w_gate"]
    up = xn @ lw["w_up"]
    t = xn.shape[1]
    padded = jnp.concatenate([conv_prev.astype(gate.dtype), gate], axis=1)
    conv = lw["conv_b"] + sum(lw["conv_w"][k] * padded[:, k:k + t] for k in range(CONV_W))
    h = jax.nn.silu(conv) * up
    return h @ lw["w_down"], padded[:, t:]


def hybrid_layer(x, pos, h0_re, h0_im, conv_prev, attention, lw):
    xn = rmsnorm(x, lw["g_mix"])
    u, q_lat, q_rope, ckv, kr = project_mixers(xn, pos, lw)
    y_s5, h_re, h_im = s5_mixer(u, h0_re, h0_im, lw)
    o_lat = attention(q_lat, q_rope, ckv, kr, pos)
    y_mla = jnp.einsum("bthr,rhv->bthv", o_lat, lw["w_uv"]).reshape(x.shape[0], x.shape[1], MLA_HEADS * V_HEAD)
    x = x + jnp.concatenate([y_s5, y_mla], axis=-1) @ lw["w_out"]
    f, conv_new = conv_ffn(rmsnorm(x, lw["g_ffn"]), conv_prev, lw)
    x = x + f
    return x, ckv, kr, h_re, h_im, conv_new


def setup_inputs(seed: int = 0) -> dict:
    key = jax.random.key(seed)
    ks = jax.random.split(key, 40)

    def nrm(k, shape, scale=1.0):
        return jax.random.normal(k, shape, F32) * scale

    def gain(k, shape):
        return 1.0 + 0.02 * jax.random.normal(k, shape, F32)

    page_table = jax.random.permutation(ks[7], N_POOL)[:DEC_BATCH * N_PAGES].reshape(DEC_BATCH, N_PAGES).astype(jnp.int32)
    a_im = jnp.pi * jnp.arange(S5_STATE, dtype=F32)
    return {
        "x_prompt": nrm(ks[0], (BATCH, SEQ, D_MODEL)),
        "x_sample": nrm(ks[1], (DEC_BATCH, DEC_SEQ, D_MODEL)),
        "cache_ckv": nrm(ks[2], (DEPTH, N_POOL, PAGE_SIZE, KV_RANK)),
        "cache_kr": nrm(ks[3], (DEPTH, N_POOL, PAGE_SIZE, QK_ROPE)),
        "state_s5_re": nrm(ks[4], (DEPTH, DEC_BATCH, S5_GROUPS, S5_STATE), 0.1),
        "state_s5_im": nrm(ks[5], (DEPTH, DEC_BATCH, S5_GROUPS, S5_STATE), 0.1),
        "state_conv": nrm(ks[6], (DEPTH, DEC_BATCH, CONV_W - 1, D_FF)),
        "page_table": page_table,
        "meta_tokens": nrm(ks[8], (N_META, D_MODEL)),
        "g_mix": gain(ks[9], (DEPTH, D_MODEL)),
        "w_in": nrm(ks[10], (DEPTH, D_MODEL, IN_W), D_MODEL ** -0.5),
        "g_q": gain(ks[11], (DEPTH, Q_RANK)),
        "w_uq": nrm(ks[12], (DEPTH, Q_RANK, MLA_HEADS * (QK_NOPE + QK_ROPE)), Q_RANK ** -0.5),
        "g_kv": gain(ks[13], (DEPTH, KV_RANK)),
        "w_uk": nrm(ks[14], (DEPTH, KV_RANK, MLA_HEADS, QK_NOPE), KV_RANK ** -0.5),
        "w_uv": nrm(ks[15], (DEPTH, KV_RANK, MLA_HEADS, V_HEAD), KV_RANK ** -0.5),
        "s5_a_re": -0.5 + nrm(ks[16], (DEPTH, S5_GROUPS, S5_STATE), 0.01),
        "s5_a_im": a_im + nrm(ks[17], (DEPTH, S5_GROUPS, S5_STATE), 0.01),
        "s5_log_dt": jax.random.uniform(ks[18], (DEPTH, S5_GROUPS), F32, math.log(1e-3), math.log(1e-1)),
        "s5_b_re": nrm(ks[19], (DEPTH, S5_GROUPS, S5_STATE, S5_GROUP), (2 * S5_GROUP) ** -0.5),
        "s5_b_im": nrm(ks[20], (DEPTH, S5_GROUPS, S5_STATE, S5_GROUP), (2 * S5_GROUP) ** -0.5),
        "s5_c_re": nrm(ks[21], (DEPTH, S5_GROUPS, S5_GROUP, S5_STATE), S5_STATE ** -0.5),
        "s5_c_im": nrm(ks[22], (DEPTH, S5_GROUPS, S5_GROUP, S5_STATE), S5_STATE ** -0.5),
        "s5_d": nrm(ks[23], (DEPTH, S5_W)),
        "w_glu": nrm(ks[24], (DEPTH, S5_W, S5_W), S5_W ** -0.5),
        "w_out": nrm(ks[25], (DEPTH, MIX_W, D_MODEL), MIX_W ** -0.5),
        "g_ffn": gain(ks[26], (DEPTH, D_MODEL)),
        "w_gate": nrm(ks[27], (DEPTH, D_MODEL, D_FF), D_MODEL ** -0.5),
        "w_up": nrm(ks[28], (DEPTH, D_MODEL, D_FF), D_MODEL ** -0.5),
        "conv_w": nrm(ks[29], (DEPTH, CONV_W, D_FF), CONV_W ** -0.5),
        "conv_b": nrm(ks[30], (DEPTH, D_FF), 0.01),
        "w_down": nrm(ks[31], (DEPTH, D_FF, D_MODEL), D_FF ** -0.5),
        "g_final": gain(ks[32], (D_MODEL,)),
    }


def reference(x_prompt, x_sample, cache_ckv, cache_kr, state_s5_re, state_s5_im, state_conv, page_table,
              meta_tokens, g_mix, w_in, g_q, w_uq, g_kv, w_uk, w_uv, s5_a_re, s5_a_im, s5_log_dt,
              s5_b_re, s5_b_im, s5_c_re, s5_c_im, s5_d, w_glu, w_out, g_ffn, w_gate, w_up, conv_w, conv_b,
              w_down, g_final):
    b = x_prompt.shape[0]
    db = x_sample.shape[0]
    t_p = N_META + x_prompt.shape[1]
    t_s = x_sample.shape[1]
    n_past = page_table.shape[1] * PAGE_SIZE

    hp = jnp.concatenate([jnp.broadcast_to(meta_tokens.astype(x_prompt.dtype)[None], (b, N_META, D_MODEL)), x_prompt], axis=1)
    hs = x_sample
    pos_p = jnp.arange(t_p, dtype=jnp.int32)
    pos_s = n_past + jnp.arange(t_s, dtype=jnp.int32)
    h0_zero = jnp.zeros((b, S5_GROUPS, S5_STATE), F32)
    conv_zero = jnp.zeros((b, CONV_W - 1, D_FF), x_prompt.dtype)

    ckv_p_l, kr_p_l, sre_p_l, sim_p_l, conv_p_l = [], [], [], [], []
    ckv_s_l, kr_s_l, sre_s_l, sim_s_l, conv_s_l = [], [], [], [], []
    for l in range(DEPTH):
        lw = dict(g_mix=g_mix[l], w_in=w_in[l], g_q=g_q[l], w_uq=w_uq[l], g_kv=g_kv[l], w_uk=w_uk[l],
                  w_uv=w_uv[l], s5_a_re=s5_a_re[l], s5_a_im=s5_a_im[l], s5_log_dt=s5_log_dt[l],
                  s5_b_re=s5_b_re[l], s5_b_im=s5_b_im[l], s5_c_re=s5_c_re[l], s5_c_im=s5_c_im[l],
                  s5_d=s5_d[l], w_glu=w_glu[l], w_out=w_out[l], g_ffn=g_ffn[l], w_gate=w_gate[l],
                  w_up=w_up[l], conv_w=conv_w[l], conv_b=conv_b[l], w_down=w_down[l])
        hp, ckv_p, kr_p, sre_p, sim_p, conv_p = hybrid_layer(hp, pos_p, h0_zero, h0_zero, conv_zero, prompt_attention, lw)
        past_ckv = cache_ckv[l, page_table].reshape(db, n_past, KV_RANK)
        past_kr = cache_kr[l, page_table].reshape(db, n_past, QK_ROPE)
        attn_s = functools.partial(sample_attention, past_ckv=past_ckv, past_kr=past_kr)
        hs, ckv_s, kr_s, sre_s, sim_s, conv_s = hybrid_layer(hs, pos_s, state_s5_re[l], state_s5_im[l], state_conv[l], attn_s, lw)
        ckv_p_l.append(ckv_p); kr_p_l.append(kr_p); sre_p_l.append(sre_p); sim_p_l.append(sim_p); conv_p_l.append(conv_p)
        ckv_s_l.append(ckv_s); kr_s_l.append(kr_s); sre_s_l.append(sre_s); sim_s_l.append(sim_s); conv_s_l.append(conv_s)

    y_prompt = rmsnorm(hp[:, N_META:], g_final)
    y_sample = rmsnorm(hs, g_final)
    return (y_prompt, y_sample,
            jnp.stack(ckv_p_l), jnp.stack(kr_p_l), jnp.stack(sre_p_l), jnp.stack(sim_p_l), jnp.stack(conv_p_l),
            jnp.stack(ckv_s_l), jnp.stack(kr_s_l), jnp.stack(sre_s_l), jnp.stack(sim_s_l), jnp.stack(conv_s_l))
```

```cpp
#include <hip/hip_runtime.h>
#include <math.h>
namespace nv {
constexpr int D_MODEL = 1024, BATCH = 4, SEQ = 4096, DEC_BATCH = 128, DEC_SEQ = 8, PAST_LEN = 8192, PAGE_SIZE = 128;
constexpr int N_META = 16, S5_W = 512, S5_GROUP = 16, S5_GROUPS = 32, S5_STATE = 64, MLA_HEADS = 4, QK_NOPE = 128, QK_ROPE = 64, V_HEAD = 128;
constexpr int Q_RANK = 384, KV_RANK = 256, D_FF = 2816, IN_W = 1216, N_PAGES = 64, N_POOL = 10240;
constexpr int TP = N_META + SEQ;
constexpr int RP = BATCH * TP;
constexpr int RS = DEC_BATCH * DEC_SEQ;
constexpr int R = RP + RS;
constexpr float EPS = 1e-6f;
constexpr float ATTN_SCALE = 0.07216878364870322f;
constexpr size_t O_YP = 0, O_YS = O_YP + (size_t)BATCH * SEQ * D_MODEL, O_CKVP = O_YS + (size_t)RS * D_MODEL, O_KRP = O_CKVP + (size_t)RP * KV_RANK,
                 O_SREP = O_KRP + (size_t)RP * QK_ROPE, O_SIMP = O_SREP + BATCH * S5_GROUPS * S5_STATE, O_CONVP = O_SIMP + BATCH * S5_GROUPS * S5_STATE,
                 O_CKVS = O_CONVP + BATCH * 2 * D_FF, O_KRS = O_CKVS + (size_t)RS * KV_RANK, O_SRES = O_KRS + (size_t)RS * QK_ROPE,
                 O_SIMS = O_SRES + DEC_BATCH * S5_GROUPS * S5_STATE, O_CONVS = O_SIMS + DEC_BATCH * S5_GROUPS * S5_STATE, O_END = O_CONVS + (size_t)DEC_BATCH * 2 * D_FF;

__device__ __forceinline__ float wsum(float v) {
#pragma unroll
    for (int o = 1; o < 64; o <<= 1) v += __shfl_xor(v, o);
    return v;
}
__device__ __forceinline__ int row_pos(int r) { return r < RP ? (r % TP) : (PAST_LEN + ((r - RP) & 7)); }
__device__ __forceinline__ int row_posidx(int r) { return r < RP ? (r % TP) : (TP + ((r - RP) & 7)); }

__global__ void k_setup(float* rope_cos, float* rope_sin, const float* a_re, const float* a_im, const float* log_dt, const float* b_re, const float* b_im,
                        float* abar_re, float* abar_im, float* bbar_re, float* bbar_im) {
    const int gid = blockIdx.x * blockDim.x + threadIdx.x, nth = gridDim.x * blockDim.x;
    for (int i = gid; i < (TP + DEC_SEQ) * 32; i += nth) {
        const int pi = i / 32, f = i % 32; const int pos = pi < TP ? pi : PAST_LEN + (pi - TP);
        const double inv = pow(10000.0, -(double)f / 32.0), ang = (double)pos * inv;
        rope_cos[i] = (float)cos(ang); rope_sin[i] = (float)sin(ang);
    }
    for (int i = gid; i < S5_GROUPS * S5_STATE; i += nth) {
        const int g = i / S5_STATE;
        const double dt = exp((double)log_dt[g]), ar = a_re[i], ai = a_im[i];
        const double mag = exp(dt * ar), cr = mag * cos(dt * ai), ci = mag * sin(dt * ai);
        const double nr = cr - 1.0, ni = ci, den = ar * ar + ai * ai;
        const double fr = (nr * ar + ni * ai) / den, fi = (ni * ar - nr * ai) / den;
        abar_re[i] = (float)cr; abar_im[i] = (float)ci;
        for (int j = 0; j < S5_GROUP; ++j) { const double br = b_re[i * S5_GROUP + j], bi = b_im[i * S5_GROUP + j];
            bbar_re[i * S5_GROUP + j] = (float)(fr * br - fi * bi); bbar_im[i * S5_GROUP + j] = (float)(fr * bi + fi * br); }
    }
}
__global__ void k_embed_norm(const float* x_prompt, const float* x_sample, const float* meta, const float* g, float* x0, float* xn) {
    const int wave = (blockIdx.x * blockDim.x + threadIdx.x) >> 6, lane = threadIdx.x & 63, nw = (gridDim.x * blockDim.x) >> 6;
    for (int r = wave; r < R; r += nw) {
        const float* src;
        if (r < RP) { const int b = r / TP, t = r % TP; src = t < N_META ? meta + (size_t)t * D_MODEL : x_prompt + ((size_t)b * SEQ + (t - N_META)) * D_MODEL; }
        else src = x_sample + (size_t)(r - RP) * D_MODEL;
        float v[16]; float s = 0.f;
#pragma unroll
        for (int j = 0; j < 16; ++j) { v[j] = src[lane + 64 * j]; s += v[j] * v[j]; }
        s = wsum(s); const float rs = 1.0f / sqrtf(s * (1.0f / D_MODEL) + EPS);
#pragma unroll
        for (int j = 0; j < 16; ++j) { x0[(size_t)r * D_MODEL + lane + 64 * j] = v[j]; xn[(size_t)r * D_MODEL + lane + 64 * j] = v[j] * rs * g[lane + 64 * j]; }
    }
}
__global__ void k_rmsnorm(const float* in, int ldi, float* out, int ldo, const float* g, int ncols, int nrows) {
    const int wave = (blockIdx.x * blockDim.x + threadIdx.x) >> 6, lane = threadIdx.x & 63, nw = (gridDim.x * blockDim.x) >> 6;
    for (int r = wave; r < nrows; r += nw) {
        float s = 0.f;
        for (int c = lane; c < ncols; c += 64) { const float v = in[(size_t)r * ldi + c]; s += v * v; }
        s = wsum(s); const float rs = 1.0f / sqrtf(s / (float)ncols + EPS);
        for (int c = lane; c < ncols; c += 64) out[(size_t)r * ldo + c] = in[(size_t)r * ldi + c] * rs * g[c];
    }
}
__global__ void k_rope(const float* in, int ldi, int hstride, float* out, int ldo, int nh, const float* rope_cos, const float* rope_sin) {
    const int gid = blockIdx.x * blockDim.x + threadIdx.x, nth = gridDim.x * blockDim.x;
    for (long i = gid; i < (long)R * nh * 32; i += nth) {
        const int f = (int)(i % 32), h = (int)((i / 32) % nh), r = (int)(i / (32 * nh));
        const int pi = row_posidx(r); const float c = rope_cos[pi * 32 + f], s = rope_sin[pi * 32 + f];
        const float x1 = in[(size_t)r * ldi + h * hstride + f], x2 = in[(size_t)r * ldi + h * hstride + 32 + f];
        out[(size_t)r * ldo + h * 64 + f] = x1 * c - x2 * s; out[(size_t)r * ldo + h * 64 + 32 + f] = x1 * s + x2 * c;
    }
}
__global__ void k_rows_out(const float* in, int ncols, float* outp, float* outs) {
    const int gid = blockIdx.x * blockDim.x + threadIdx.x, nth = gridDim.x * blockDim.x;
    for (long i = gid; i < (long)R * ncols; i += nth) { const int r = (int)(i / ncols), c = (int)(i % ncols);
        if (r < RP) outp[(size_t)r * ncols + c] = in[i]; else outs[(size_t)(r - RP) * ncols + c] = in[i]; }
}
__global__ void __launch_bounds__(256) k_gemm(const float* A, int lda, const float* B, long sbk, long sbn, float* C, int ldc, const float* add, int M, int N, int K) {
    __shared__ float As[16][68], Bs[16][68];
    const int tx = threadIdx.x & 15, ty = threadIdx.x >> 4, m0 = blockIdx.y * 64, n0 = blockIdx.x * 64;
    float acc[4][4];
#pragma unroll
    for (int i = 0; i < 4; ++i)
#pragma unroll
        for (int j = 0; j < 4; ++j) acc[i][j] = 0.f;
    for (int k0 = 0; k0 < K; k0 += 16) {
#pragma unroll
        for (int i = 0; i < 4; ++i) { const int e = threadIdx.x + 256 * i;
            { const int mm = e >> 4, kk = e & 15; As[kk][mm] = (m0 + mm < M) ? A[(size_t)(m0 + mm) * lda + k0 + kk] : 0.f; }
            { const int kk = e >> 6, nn = e & 63; Bs[kk][nn] = (n0 + nn < N) ? B[(size_t)(k0 + kk) * sbk + (size_t)(n0 + nn) * sbn] : 0.f; } }
        __syncthreads();
#pragma unroll
        for (int kk = 0; kk < 16; ++kk) { float a[4], b[4];
#pragma unroll
            for (int i = 0; i < 4; ++i) { a[i] = As[kk][ty * 4 + i]; b[i] = Bs[kk][tx * 4 + i]; }
#pragma unroll
            for (int i = 0; i < 4; ++i)
#pragma unroll
                for (int j = 0; j < 4; ++j) acc[i][j] += a[i] * b[j]; }
        __syncthreads();
    }
#pragma unroll
    for (int i = 0; i < 4; ++i)
#pragma unroll
        for (int j = 0; j < 4; ++j) { const int m = m0 + ty * 4 + i, n = n0 + tx * 4 + j;
            if (m < M && n < N) C[(size_t)m * ldc + n] = acc[i][j] + (add ? add[(size_t)m * ldc + n] : 0.f); }
}
inline void gemm(hipStream_t st, const float* A, int lda, const float* B, long sbk, long sbn, float* C, int ldc, const float* add, int M, int N, int K) {
    k_gemm<<<dim3((N + 63) / 64, (M + 63) / 64), 256, 0, st>>>(A, lda, B, sbk, sbn, C, ldc, add, M, N, K);
}
__device__ __forceinline__ float gelu_tanh(float x) { const float u = 0.7978845608028654f * (x + 0.044715f * x * x * x); return 0.5f * x * (1.0f + tanhf(u)); }
__global__ void __launch_bounds__(64) k_s5(const float* z  , const float* abar_re, const float* abar_im, const float* bbar_re, const float* bbar_im,
                                           const float* c_re, const float* c_im, const float* dskip, const float* st_re, const float* st_im, float* ys5a  , float* out) {
    __shared__ float part[64][17]; __shared__ float us[16];
    const int g = blockIdx.x % S5_GROUPS, seq = blockIdx.x / S5_GROUPS, p = threadIdx.x;
    const bool prompt = seq < BATCH; const int db = seq - BATCH; const int T = prompt ? TP : DEC_SEQ; const int row0 = prompt ? seq * TP : RP + db * DEC_SEQ;
    const int gp = g * S5_STATE + p;
    const float ar = abar_re[gp], ai = abar_im[gp];
    float br[16], bi[16], cr[16], ci[16];
#pragma unroll
    for (int j = 0; j < 16; ++j) { br[j] = bbar_re[gp * 16 + j]; bi[j] = bbar_im[gp * 16 + j]; cr[j] = c_re[(g * 16 + j) * S5_STATE + p]; ci[j] = c_im[(g * 16 + j) * S5_STATE + p]; }
    float hr = prompt ? 0.f : st_re[(size_t)db * 2048 + gp], hi = prompt ? 0.f : st_im[(size_t)db * 2048 + gp];
    const float dk = p < 16 ? dskip[g * 16 + p] : 0.f;
    for (int t = 0; t < T; ++t) {
        if (p < 16) us[p] = z[(size_t)(row0 + t) * IN_W + g * 16 + p];
        __syncthreads();
        float bur = 0.f, bui = 0.f;
#pragma unroll
        for (int j = 0; j < 16; ++j) { const float u = us[j]; bur += br[j] * u; bui += bi[j] * u; }
        const float nr = ar * hr - ai * hi + bur, ni = ar * hi + ai * hr + bui; hr = nr; hi = ni;
#pragma unroll
        for (int j = 0; j < 16; ++j) part[p][j] = cr[j] * hr - ci[j] * hi;
        __syncthreads();
        if (p < 16) { float s = 0.f; for (int q = 0; q < 64; ++q) s += part[q][p]; s += dk * us[p]; ys5a[(size_t)(row0 + t) * S5_W + g * 16 + p] = gelu_tanh(s); }
        __syncthreads();
    }
    if (prompt) { out[O_SREP + (size_t)seq * 2048 + gp] = hr; out[O_SIMP + (size_t)seq * 2048 + gp] = hi; }
    else { out[O_SRES + (size_t)db * 2048 + gp] = hr; out[O_SIMS + (size_t)db * 2048 + gp] = hi; }
}
__global__ void k_glu(const float* ys5a, const float* lin, float* cat) {
    const int gid = blockIdx.x * blockDim.x + threadIdx.x, nth = gridDim.x * blockDim.x;
    for (long i = gid; i < (long)R * S5_W; i += nth) { const int r = (int)(i / S5_W), c = (int)(i % S5_W); const float y = ys5a[i], l = lin[i];
        cat[(size_t)r * 1024 + c] = y * (1.0f / (1.0f + expf(-l))); }
}
constexpr int ATT_LDS_FLOATS = 32 * 321 + 32 * 321 + 32 * 33 + 32 * 3;
__global__ void __launch_bounds__(256) k_attn(const float* q_lat  , const float* q_rope  , const float* ckv  , const float* kr  ,
                                              const float* cache_ckv, const float* cache_kr, const int* page_table, float* o_lat  ) {
    extern __shared__ float sm[];
    float* Qs = sm;
    float* Ks = Qs + 32 * 321;
    float* Ps = Ks + 32 * 321;
    float* mrow = Ps + 32 * 33;
    float* lrow = mrow + 32;
    float* srow = lrow + 32;
    const int tid = threadIdx.x;
    const int NPB = 514;
    const bool prompt = blockIdx.x < BATCH * NPB;
    int rowq0, nkeys, b = 0, q0 = 0, db = 0;
    if (prompt) { b = blockIdx.x / NPB; q0 = 8 * (blockIdx.x % NPB); rowq0 = b * TP + q0; nkeys = q0 + 8; }
    else { db = blockIdx.x - BATCH * NPB; rowq0 = RP + db * 8; nkeys = PAST_LEN + 8; }
    for (int e = tid; e < 32 * 320; e += 256) { const int m = e / 320, d = e % 320, qi = m >> 2, h = m & 3; const int r = rowq0 + qi;
        Qs[m * 321 + d] = d < 256 ? q_lat[((size_t)r * 4 + h) * 256 + d] : q_rope[((size_t)r * 4 + h) * 64 + (d - 256)]; }
    if (tid < 32) { mrow[tid] = -INFINITY; lrow[tid] = 0.f; }
    float oacc[32];
#pragma unroll
    for (int m = 0; m < 32; ++m) oacc[m] = 0.f;
    __syncthreads();
    const int ntiles = (nkeys + 31) / 32;
    for (int kt = 0; kt < ntiles; ++kt) {
        for (int e = tid; e < 32 * 320; e += 256) { const int kk = e / 320, d = e % 320, j = kt * 32 + kk; float v = 0.f;
            if (j < nkeys) {
                if (prompt) { const size_t r = (size_t)b * TP + j; v = d < 256 ? ckv[r * 256 + d] : kr[r * 64 + (d - 256)]; }
                else if (j < PAST_LEN) { const size_t pg = (size_t)page_table[db * N_PAGES + (j >> 7)], rr = pg * PAGE_SIZE + (j & 127); v = d < 256 ? cache_ckv[rr * 256 + d] : cache_kr[rr * 64 + (d - 256)]; }
                else { const size_t r = (size_t)RP + db * 8 + (j - PAST_LEN); v = d < 256 ? ckv[r * 256 + d] : kr[r * 64 + (d - 256)]; }
            }
            Ks[kk * 321 + d] = v; }
        __syncthreads();
#pragma unroll
        for (int i = 0; i < 4; ++i) { const int e = tid + 256 * i, m = e >> 5, kk = e & 31, j = kt * 32 + kk, qi = m >> 2;
            float s = 0.f; for (int d = 0; d < 320; ++d) s += Qs[m * 321 + d] * Ks[kk * 321 + d];
            s *= ATTN_SCALE;
            bool vis;
            if (prompt) vis = (j <= q0 + qi); else vis = (j < PAST_LEN) || (j - PAST_LEN <= qi);
            if (j >= nkeys) vis = false;
            Ps[m * 33 + kk] = vis ? s : -INFINITY; }
        __syncthreads();
        if (tid < 32) { const int m = tid; float mx = mrow[m]; const float mold = mx;
            for (int kk = 0; kk < 32; ++kk) mx = fmaxf(mx, Ps[m * 33 + kk]);
            const float sc = (mold == -INFINITY) ? 0.f : expf(mold - mx); float l = lrow[m] * sc;
            for (int kk = 0; kk < 32; ++kk) { const float s = Ps[m * 33 + kk]; const float pv = (s == -INFINITY) ? 0.f : expf(s - mx); Ps[m * 33 + kk] = pv; l += pv; }
            mrow[m] = mx; lrow[m] = l; srow[m] = sc; }
        __syncthreads();
#pragma unroll
        for (int m = 0; m < 32; ++m) oacc[m] *= srow[m];
        for (int kk = 0; kk < 32; ++kk) { const float v = Ks[kk * 321 + tid];
#pragma unroll
            for (int m = 0; m < 32; ++m) oacc[m] += Ps[m * 33 + kk] * v; }
        __syncthreads();
    }
#pragma unroll
    for (int m = 0; m < 32; ++m) { const int qi = m >> 2, h = m & 3; o_lat[((size_t)(rowq0 + qi) * 4 + h) * 256 + tid] = oacc[m] / lrow[m]; }
}
__global__ void k_convgate(const float* gate, const float* up, const float* state_conv, const float* conv_w, const float* conv_b, float* h, float* out) {
    const int gid = blockIdx.x * blockDim.x + threadIdx.x, nth = gridDim.x * blockDim.x;
    for (long i = gid; i < (long)R * D_FF; i += nth) { const int r = (int)(i / D_FF), f = (int)(i % D_FF);
        float g0, g1, g2 = gate[i];
        if (r < RP) { const int t = r % TP; g1 = t >= 1 ? gate[i - D_FF] : 0.f; g0 = t >= 2 ? gate[i - 2 * D_FF] : 0.f; }
        else { const int s = r - RP, db = s >> 3, t = s & 7;
            g1 = t >= 1 ? gate[i - D_FF] : state_conv[((size_t)db * 2 + 1) * D_FF + f];
            g0 = t >= 2 ? gate[i - 2 * D_FF] : state_conv[((size_t)db * 2 + t) * D_FF + f]; }
        const float c = conv_b[f] + conv_w[f] * g0 + conv_w[D_FF + f] * g1 + conv_w[2 * D_FF + f] * g2;
        h[i] = c / (1.0f + expf(-c)) * up[i];
        if (r < RP) { const int b = r / TP, t = r % TP; if (t >= TP - 2) out[O_CONVP + ((size_t)b * 2 + (t - (TP - 2))) * D_FF + f] = g2; }
        else { const int s = r - RP, db = s >> 3, t = s & 7; if (t >= 6) out[O_CONVS + ((size_t)db * 2 + (t - 6)) * D_FF + f] = g2; }
    }
}
__global__ void k_final(const float* x2, const float* g, float* out) {
    const int wave = (blockIdx.x * blockDim.x + threadIdx.x) >> 6, lane = threadIdx.x & 63, nw = (gridDim.x * blockDim.x) >> 6;
    for (int r = wave; r < R; r += nw) {
        float* dst;
        if (r < RP) { const int b = r / TP, t = r % TP; if (t < N_META) continue; dst = out + O_YP + ((size_t)b * SEQ + (t - N_META)) * D_MODEL; }
        else dst = out + O_YS + (size_t)(r - RP) * D_MODEL;
        float v[16]; float s = 0.f;
#pragma unroll
        for (int j = 0; j < 16; ++j) { v[j] = x2[(size_t)r * D_MODEL + lane + 64 * j]; s += v[j] * v[j]; }
        s = wsum(s); const float rs = 1.0f / sqrtf(s * (1.0f / D_MODEL) + EPS);
#pragma unroll
        for (int j = 0; j < 16; ++j) dst[lane + 64 * j] = v[j] * rs * g[lane + 64 * j];
    }
}

struct WS {
    float *rope_cos, *rope_sin, *abar_re, *abar_im, *bbar_re, *bbar_im;
    float *x0, *xn, *z, *cqn, *q, *q_lat, *q_rope, *ckv, *kr, *ys5a, *lin, *cat, *o_lat, *x1, *xn2, *gate, *up, *h, *x2;
};
inline WS carve(float* base) {
    WS w; float* p = base;
    auto take = [&](size_t n) { float* r = p; p += (n + 63) / 64 * 64; return r; };
    w.rope_cos = take((TP + 8) * 32); w.rope_sin = take((TP + 8) * 32); w.abar_re = take(2048); w.abar_im = take(2048); w.bbar_re = take(2048 * 16); w.bbar_im = take(2048 * 16);
    w.x0 = take((size_t)R * 1024); w.xn = take((size_t)R * 1024); w.z = take((size_t)R * IN_W); w.cqn = take((size_t)R * 384); w.q = take((size_t)R * 768);
    w.q_lat = take((size_t)R * 1024); w.q_rope = take((size_t)R * 256); w.ckv = take((size_t)R * 256); w.kr = take((size_t)R * 64); w.ys5a = take((size_t)R * 512);
    w.lin = take((size_t)R * 512); w.cat = take((size_t)R * 1024); w.o_lat = take((size_t)R * 1024); w.x1 = take((size_t)R * 1024); w.xn2 = take((size_t)R * 1024);
    w.gate = take((size_t)R * D_FF); w.up = take((size_t)R * D_FF); w.h = take((size_t)R * D_FF); w.x2 = take((size_t)R * 1024);
    return w;
}
constexpr size_t WS_FLOATS = (size_t)R * (1024 * 8 + IN_W + 384 + 768 + 256 + 256 + 64 + 512 + 512 + 3 * D_FF) + 400000;

inline void forward(void* const* d_in, float* out, const WS& w, hipStream_t st) {
    const float* x_prompt = (const float*)d_in[0]; const float* x_sample = (const float*)d_in[1]; const float* cache_ckv = (const float*)d_in[2]; const float* cache_kr = (const float*)d_in[3];
    const float* st_re = (const float*)d_in[4]; const float* st_im = (const float*)d_in[5]; const float* st_conv = (const float*)d_in[6]; const int* page_table = (const int*)d_in[7];
    const float* meta = (const float*)d_in[8]; const float* g_mix = (const float*)d_in[9]; const float* w_in = (const float*)d_in[10]; const float* g_q = (const float*)d_in[11];
    const float* w_uq = (const float*)d_in[12]; const float* g_kv = (const float*)d_in[13]; const float* w_uk = (const float*)d_in[14]; const float* w_uv = (const float*)d_in[15];
    const float* a_re = (const float*)d_in[16]; const float* a_im = (const float*)d_in[17]; const float* log_dt = (const float*)d_in[18]; const float* b_re = (const float*)d_in[19];
    const float* b_im = (const float*)d_in[20]; const float* c_re = (const float*)d_in[21]; const float* c_im = (const float*)d_in[22]; const float* s5_d = (const float*)d_in[23];
    const float* w_glu = (const float*)d_in[24]; const float* w_out = (const float*)d_in[25]; const float* g_ffn = (const float*)d_in[26]; const float* w_gate = (const float*)d_in[27];
    const float* w_up = (const float*)d_in[28]; const float* conv_w = (const float*)d_in[29]; const float* conv_b = (const float*)d_in[30]; const float* w_down = (const float*)d_in[31];
    const float* g_final = (const float*)d_in[32];
    k_setup<<<256, 256, 0, st>>>(w.rope_cos, w.rope_sin, a_re, a_im, log_dt, b_re, b_im, w.abar_re, w.abar_im, w.bbar_re, w.bbar_im);
    k_embed_norm<<<2048, 256, 0, st>>>(x_prompt, x_sample, meta, g_mix, w.x0, w.xn);
    gemm(st, w.xn, 1024, w_in, IN_W, 1, w.z, IN_W, nullptr, R, IN_W, 1024);
    k_rmsnorm<<<2048, 256, 0, st>>>(w.z + 512, IN_W, w.cqn, 384, g_q, 384, R);
    k_rmsnorm<<<2048, 256, 0, st>>>(w.z + 896, IN_W, w.ckv, 256, g_kv, 256, R);
    k_rope<<<2048, 256, 0, st>>>(w.z + 1152, IN_W, 0, w.kr, 64, 1, w.rope_cos, w.rope_sin);
    k_rows_out<<<2048, 256, 0, st>>>(w.ckv, 256, out + O_CKVP, out + O_CKVS);
    k_rows_out<<<2048, 256, 0, st>>>(w.kr, 64, out + O_KRP, out + O_KRS);
    gemm(st, w.cqn, 384, w_uq, 768, 1, w.q, 768, nullptr, R, 768, 384);
    for (int h = 0; h < 4; ++h) gemm(st, w.q + h * 192, 768, w_uk + h * 128, 1, 512, w.q_lat + h * 256, 1024, nullptr, R, 256, 128);
    k_rope<<<2048, 256, 0, st>>>(w.q + 128, 768, 192, w.q_rope, 256, 4, w.rope_cos, w.rope_sin);
    k_s5<<<(BATCH + DEC_BATCH) * S5_GROUPS, 64, 0, st>>>(w.z, w.abar_re, w.abar_im, w.bbar_re, w.bbar_im, c_re, c_im, s5_d, st_re, st_im, w.ys5a, out);
    gemm(st, w.ys5a, 512, w_glu, 512, 1, w.lin, 512, nullptr, R, 512, 512);
    k_glu<<<2048, 256, 0, st>>>(w.ys5a, w.lin, w.cat);
    k_attn<<<BATCH * 514 + DEC_BATCH, 256, ATT_LDS_FLOATS * 4, st>>>(w.q_lat, w.q_rope, w.ckv, w.kr, cache_ckv, cache_kr, page_table, w.o_lat);
    for (int h = 0; h < 4; ++h) gemm(st, w.o_lat + h * 256, 1024, w_uv + h * 128, 512, 1, w.cat + 512 + h * 128, 1024, nullptr, R, 128, 256);
    gemm(st, w.cat, 1024, w_out, 1024, 1, w.x1, 1024, w.x0, R, 1024, 1024);
    k_rmsnorm<<<2048, 256, 0, st>>>(w.x1, 1024, w.xn2, 1024, g_ffn, 1024, R);
    gemm(st, w.xn2, 1024, w_gate, D_FF, 1, w.gate, D_FF, nullptr, R, D_FF, 1024);
    gemm(st, w.xn2, 1024, w_up, D_FF, 1, w.up, D_FF, nullptr, R, D_FF, 1024);
    k_convgate<<<4096, 256, 0, st>>>(w.gate, w.up, st_conv, conv_w, conv_b, w.h, out);
    gemm(st, w.h, D_FF, w_down, 1024, 1, w.x2, 1024, w.x1, R, 1024, D_FF);
    k_final<<<2048, 256, 0, st>>>(w.x2, g_final, out);
}
}
extern "C" void kernel_launch(void* const* d_in, const int* in_sizes, int n_in,
                              void* d_out, int out_size, void* d_ws, size_t ws_size,
                              hipStream_t stream) {
    static bool attr = false;
    if (!attr) { (void)hipFuncSetAttribute((const void*)nv::k_attn, hipFuncAttributeMaxDynamicSharedMemorySize, nv::ATT_LDS_FLOATS * 4); attr = true; }
    nv::WS w = nv::carve((float*)d_ws);
    nv::forward(d_in, (float*)d_out, w, stream);
}
```

```cpp
#include <hip/hip_runtime.h>
#include <math.h>
namespace nv {
constexpr int D_MODEL = 1024, BATCH = 4, SEQ = 4096, DEC_BATCH = 128, DEC_SEQ = 8, PAST_LEN = 8192, PAGE_SIZE = 128;
constexpr int N_META = 16, S5_W = 512, S5_GROUP = 16, S5_GROUPS = 32, S5_STATE = 64, MLA_HEADS = 4, QK_NOPE = 128, QK_ROPE = 64, V_HEAD = 128;
constexpr int Q_RANK = 384, KV_RANK = 256, D_FF = 2816, IN_W = 1216, N_PAGES = 64, N_POOL = 10240;
constexpr int TP = N_META + SEQ;
constexpr int RP = BATCH * TP;
constexpr int RS = DEC_BATCH * DEC_SEQ;
constexpr int R = RP + RS;
constexpr float EPS = 1e-6f;
constexpr float ATTN_SCALE = 0.07216878364870322f;
constexpr size_t O_YP = 0, O_YS = O_YP + (size_t)BATCH * SEQ * D_MODEL, O_CKVP = O_YS + (size_t)RS * D_MODEL, O_KRP = O_CKVP + (size_t)RP * KV_RANK,
                 O_SREP = O_KRP + (size_t)RP * QK_ROPE, O_SIMP = O_SREP + BATCH * S5_GROUPS * S5_STATE, O_CONVP = O_SIMP + BATCH * S5_GROUPS * S5_STATE,
                 O_CKVS = O_CONVP + BATCH * 2 * D_FF, O_KRS = O_CKVS + (size_t)RS * KV_RANK, O_SRES = O_KRS + (size_t)RS * QK_ROPE,
                 O_SIMS = O_SRES + DEC_BATCH * S5_GROUPS * S5_STATE, O_CONVS = O_SIMS + DEC_BATCH * S5_GROUPS * S5_STATE, O_END = O_CONVS + (size_t)DEC_BATCH * 2 * D_FF;

__device__ __forceinline__ float wsum(float v) {
#pragma unroll
    for (int o = 1; o < 64; o <<= 1) v += __shfl_xor(v, o);
    return v;
}
__device__ __forceinline__ int row_pos(int r) { return r < RP ? (r % TP) : (PAST_LEN + ((r - RP) & 7)); }
__device__ __forceinline__ int row_posidx(int r) { return r < RP ? (r % TP) : (TP + ((r - RP) & 7)); }

__global__ void k_setup(float* rope_cos, float* rope_sin, const float* a_re, const float* a_im, const float* log_dt, const float* b_re, const float* b_im,
                        float* abar_re, float* abar_im, float* bbar_re, float* bbar_im) {
    const int gid = blockIdx.x * blockDim.x + threadIdx.x, nth = gridDim.x * blockDim.x;
    for (int i = gid; i < (TP + DEC_SEQ) * 32; i += nth) {
        const int pi = i / 32, f = i % 32; const int pos = pi < TP ? pi : PAST_LEN + (pi - TP);
        const double inv = pow(10000.0, -(double)f / 32.0), ang = (double)pos * inv;
        rope_cos[i] = (float)cos(ang); rope_sin[i] = (float)sin(ang);
    }
    for (int i = gid; i < S5_GROUPS * S5_STATE; i += nth) {
        const int g = i / S5_STATE;
        const double dt = exp((double)log_dt[g]), ar = a_re[i], ai = a_im[i];
        const double mag = exp(dt * ar), cr = mag * cos(dt * ai), ci = mag * sin(dt * ai);
        const double nr = cr - 1.0, ni = ci, den = ar * ar + ai * ai;
        const double fr = (nr * ar + ni * ai) / den, fi = (ni * ar - nr * ai) / den;
        abar_re[i] = (float)cr; abar_im[i] = (float)ci;
        for (int j = 0; j < S5_GROUP; ++j) { const double br = b_re[i * S5_GROUP + j], bi = b_im[i * S5_GROUP + j];
            bbar_re[i * S5_GROUP + j] = (float)(fr * br - fi * bi); bbar_im[i * S5_GROUP + j] = (float)(fr * bi + fi * br); }
    }
}
__global__ void k_embed_norm(const float* x_prompt, const float* x_sample, const float* meta, const float* g, float* x0, float* xn) {
    const int wave = (blockIdx.x * blockDim.x + threadIdx.x) >> 6, lane = threadIdx.x & 63, nw = (gridDim.x * blockDim.x) >> 6;
    for (int r = wave; r < R; r += nw) {
        const float* src;
        if (r < RP) { const int b = r / TP, t = r % TP; src = t < N_META ? meta + (size_t)t * D_MODEL : x_prompt + ((size_t)b * SEQ + (t - N_META)) * D_MODEL; }
        else src = x_sample + (size_t)(r - RP) * D_MODEL;
        float v[16]; float s = 0.f;
#pragma unroll
        for (int j = 0; j < 16; ++j) { v[j] = src[lane + 64 * j]; s += v[j] * v[j]; }
        s = wsum(s); const float rs = 1.0f / sqrtf(s * (1.0f / D_MODEL) + EPS);
#pragma unroll
        for (int j = 0; j < 16; ++j) { x0[(size_t)r * D_MODEL + lane + 64 * j] = v[j]; xn[(size_t)r * D_MODEL + lane + 64 * j] = v[j] * rs * g[lane + 64 * j]; }
    }
}
__global__ void k_rmsnorm(const float* in, int ldi, float* out, int ldo, const float* g, int ncols, int nrows) {
    const int wave = (blockIdx.x * blockDim.x + threadIdx.x) >> 6, lane = threadIdx.x & 63, nw = (gridDim.x * blockDim.x) >> 6;
    for (int r = wave; r < nrows; r += nw) {
        float s = 0.f;
        for (int c = lane; c < ncols; c += 64) { const float v = in[(size_t)r * ldi + c]; s += v * v; }
        s = wsum(s); const float rs = 1.0f / sqrtf(s / (float)ncols + EPS);
        for (int c = lane; c < ncols; c += 64) out[(size_t)r * ldo + c] = in[(size_t)r * ldi + c] * rs * g[c];
    }
}
__global__ void k_rope(const float* in, int ldi, int hstride, float* out, int ldo, int nh, const float* rope_cos, const float* rope_sin) {
    const int gid = blockIdx.x * blockDim.x + threadIdx.x, nth = gridDim.x * blockDim.x;
    for (long i = gid; i < (long)R * nh * 32; i += nth) {
        const int f = (int)(i % 32), h = (int)((i / 32) % nh), r = (int)(i / (32 * nh));
        const int pi = row_posidx(r); const float c = rope_cos[pi * 32 + f], s = rope_sin[pi * 32 + f];
        const float x1 = in[(size_t)r * ldi + h * hstride + f], x2 = in[(size_t)r * ldi + h * hstride + 32 + f];
        out[(size_t)r * ldo + h * 64 + f] = x1 * c - x2 * s; out[(size_t)r * ldo + h * 64 + 32 + f] = x1 * s + x2 * c;
    }
}
__global__ void k_rows_out(const float* in, int ncols, float* outp, float* outs) {
    const int gid = blockIdx.x * blockDim.x + threadIdx.x, nth = gridDim.x * blockDim.x;
    for (long i = gid; i < (long)R * ncols; i += nth) { const int r = (int)(i / ncols), c = (int)(i % ncols);
        if (r < RP) outp[(size_t)r * ncols + c] = in[i]; else outs[(size_t)(r - RP) * ncols + c] = in[i]; }
}
__global__ void __launch_bounds__(256) k_gemm(const float* A, int lda, const float* B, long sbk, long sbn, float* C, int ldc, const float* add, int M, int N, int K) {
    __shared__ float As[16][68], Bs[16][68];
    const int tx = threadIdx.x & 15, ty = threadIdx.x >> 4, m0 = blockIdx.y * 64, n0 = blockIdx.x * 64;
    float acc[4][4];
#pragma unroll
    for (int i = 0; i < 4; ++i)
#pragma unroll
        for (int j = 0; j < 4; ++j) acc[i][j] = 0.f;
    for (int k0 = 0; k0 < K; k0 += 16) {
#pragma unroll
        for (int i = 0; i < 4; ++i) { const int e = threadIdx.x + 256 * i;
            { const int mm = e >> 4, kk = e & 15; As[kk][mm] = (m0 + mm < M) ? A[(size_t)(m0 + mm) * lda + k0 + kk] : 0.f; }
            { const int kk = e >> 6, nn = e & 63; Bs[kk][nn] = (n0 + nn < N) ? B[(size_t)(k0 + kk) * sbk + (size_t)(n0 + nn) * sbn] : 0.f; } }
        __syncthreads();
#pragma unroll
        for (int kk = 0; kk < 16; ++kk) { float a[4], b[4];
#pragma unroll
            for (int i = 0; i < 4; ++i) { a[i] = As[kk][ty * 4 + i]; b[i] = Bs[kk][tx * 4 + i]; }
#pragma unroll
            for (int i = 0; i < 4; ++i)
#pragma unroll
                for (int j = 0; j < 4; ++j) acc[i][j] += a[i] * b[j]; }
        __syncthreads();
    }
#pragma unroll
    for (int i = 0; i < 4; ++i)
#pragma unroll
        for (int j = 0; j < 4; ++j) { const int m = m0 + ty * 4 + i, n = n0 + tx * 4 + j;
            if (m < M && n < N) C[(size_t)m * ldc + n] = acc[i][j] + (add ? add[(size_t)m * ldc + n] : 0.f); }
}
inline void gemm(hipStream_t st, const float* A, int lda, const float* B, long sbk, long sbn, float* C, int ldc, const float* add, int M, int N, int K) {
    k_gemm<<<dim3((N + 63) / 64, (M + 63) / 64), 256, 0, st>>>(A, lda, B, sbk, sbn, C, ldc, add, M, N, K);
}
__device__ __forceinline__ float gelu_tanh(float x) { const float u = 0.7978845608028654f * (x + 0.044715f * x * x * x); return 0.5f * x * (1.0f + tanhf(u)); }
__global__ void __launch_bounds__(64) k_s5(const float* z  , const float* abar_re, const float* abar_im, const float* bbar_re, const float* bbar_im,
                                           const float* c_re, const float* c_im, const float* dskip, const float* st_re, const float* st_im, float* ys5a  , float* out) {
    __shared__ float part[64][17]; __shared__ float us[16];
    const int g = blockIdx.x % S5_GROUPS, seq = blockIdx.x / S5_GROUPS, p = threadIdx.x;
    const bool prompt = seq < BATCH; const int db = seq - BATCH; const int T = prompt ? TP : DEC_SEQ; const int row0 = prompt ? seq * TP : RP + db * DEC_SEQ;
    const int gp = g * S5_STATE + p;
    const float ar = abar_re[gp], ai = abar_im[gp];
    float br[16], bi[16], cr[16], ci[16];
#pragma unroll
    for (int j = 0; j < 16; ++j) { br[j] = bbar_re[gp * 16 + j]; bi[j] = bbar_im[gp * 16 + j]; cr[j] = c_re[(g * 16 + j) * S5_STATE + p]; ci[j] = c_im[(g * 16 + j) * S5_STATE + p]; }
    float hr = prompt ? 0.f : st_re[(size_t)db * 2048 + gp], hi = prompt ? 0.f : st_im[(size_t)db * 2048 + gp];
    const float dk = p < 16 ? dskip[g * 16 + p] : 0.f;
    for (int t = 0; t < T; ++t) {
        if (p < 16) us[p] = z[(size_t)(row0 + t) * IN_W + g * 16 + p];
        __syncthreads();
        float bur = 0.f, bui = 0.f;
#pragma unroll
        for (int j = 0; j < 16; ++j) { const float u = us[j]; bur += br[j] * u; bui += bi[j] * u; }
        const float nr = ar * hr - ai * hi + bur, ni = ar * hi + ai * hr + bui; hr = nr; hi = ni;
#pragma unroll
        for (int j = 0; j < 16; ++j) part[p][j] = cr[j] * hr - ci[j] * hi;
        __syncthreads();
        if (p < 16) { float s = 0.f; for (int q = 0; q < 64; ++q) s += part[q][p]; s += dk * us[p]; ys5a[(size_t)(row0 + t) * S5_W + g * 16 + p] = gelu_tanh(s); }
        __syncthreads();
    }
    if (prompt) { out[O_SREP + (size_t)seq * 2048 + gp] = hr; out[O_SIMP + (size_t)seq * 2048 + gp] = hi; }
    else { out[O_SRES + (size_t)db * 2048 + gp] = hr; out[O_SIMS + (size_t)db * 2048 + gp] = hi; }
}
__global__ void k_glu(const float* ys5a, const float* lin, float* cat) {
    const int gid = blockIdx.x * blockDim.x + threadIdx.x, nth = gridDim.x * blockDim.x;
    for (long i = gid; i < (long)R * S5_W; i += nth) { const int r = (int)(i / S5_W), c = (int)(i % S5_W); const float y = ys5a[i], l = lin[i];
        cat[(size_t)r * 1024 + c] = y * (1.0f / (1.0f + expf(-l))); }
}
constexpr int ATT_LDS_FLOATS = 32 * 321 + 32 * 321 + 32 * 33 + 32 * 3;
__global__ void __launch_bounds__(256) k_attn(const float* q_lat  , const float* q_rope  , const float* ckv  , const float* kr  ,
                                              const float* cache_ckv, const float* cache_kr, const int* page_table, float* o_lat  ) {
    extern __shared__ float sm[];
    float* Qs = sm;
    float* Ks = Qs + 32 * 321;
    float* Ps = Ks + 32 * 321;
    float* mrow = Ps + 32 * 33;
    float* lrow = mrow + 32;
    float* srow = lrow + 32;
    const int tid = threadIdx.x;
    const int NPB = 514;
    const bool prompt = blockIdx.x < BATCH * NPB;
    int rowq0, nkeys, b = 0, q0 = 0, db = 0;
    if (prompt) { b = blockIdx.x / NPB; q0 = 8 * (blockIdx.x % NPB); rowq0 = b * TP + q0; nkeys = q0 + 8; }
    else { db = blockIdx.x - BATCH * NPB; rowq0 = RP + db * 8; nkeys = PAST_LEN + 8; }
    for (int e = tid; e < 32 * 320; e += 256) { const int m = e / 320, d = e % 320, qi = m >> 2, h = m & 3; const int r = rowq0 + qi;
        Qs[m * 321 + d] = d < 256 ? q_lat[((size_t)r * 4 + h) * 256 + d] : q_rope[((size_t)r * 4 + h) * 64 + (d - 256)]; }
    if (tid < 32) { mrow[tid] = -INFINITY; lrow[tid] = 0.f; }
    float oacc[32];
#pragma unroll
    for (int m = 0; m < 32; ++m) oacc[m] = 0.f;
    __syncthreads();
    const int ntiles = (nkeys + 31) / 32;
    for (int kt = 0; kt < ntiles; ++kt) {
        for (int e = tid; e < 32 * 320; e += 256) { const int kk = e / 320, d = e % 320, j = kt * 32 + kk; float v = 0.f;
            if (j < nkeys) {
                if (prompt) { const size_t r = (size_t)b * TP + j; v = d < 256 ? ckv[r * 256 + d] : kr[r * 64 + (d - 256)]; }
                else if (j < PAST_LEN) { const size_t pg = (size_t)page_table[db * N_PAGES + (j >> 7)], rr = pg * PAGE_SIZE + (j & 127); v = d < 256 ? cache_ckv[rr * 256 + d] : cache_kr[rr * 64 + (d - 256)]; }
                else { const size_t r = (size_t)RP + db * 8 + (j - PAST_LEN); v = d < 256 ? ckv[r * 256 + d] : kr[r * 64 + (d - 256)]; }
            }
            Ks[kk * 321 + d] = v; }
        __syncthreads();
#pragma unroll
        for (int i = 0; i < 4; ++i) { const int e = tid + 256 * i, m = e >> 5, kk = e & 31, j = kt * 32 + kk, qi = m >> 2;
            float s = 0.f; for (int d = 0; d < 320; ++d) s += Qs[m * 321 + d] * Ks[kk * 321 + d];
            s *= ATTN_SCALE;
            bool vis;
            if (prompt) vis = (j <= q0 + qi); else vis = (j < PAST_LEN) || (j - PAST_LEN <= qi);
            if (j >= nkeys) vis = false;
            Ps[m * 33 + kk] = vis ? s : -INFINITY; }
        __syncthreads();
        if (tid < 32) { const int m = tid; float mx = mrow[m]; const float mold = mx;
            for (int kk = 0; kk < 32; ++kk) mx = fmaxf(mx, Ps[m * 33 + kk]);
            const float sc = (mold == -INFINITY) ? 0.f : expf(mold - mx); float l = lrow[m] * sc;
            for (int kk = 0; kk < 32; ++kk) { const float s = Ps[m * 33 + kk]; const float pv = (s == -INFINITY) ? 0.f : expf(s - mx); Ps[m * 33 + kk] = pv; l += pv; }
            mrow[m] = mx; lrow[m] = l; srow[m] = sc; }
        __syncthreads();
#pragma unroll
        for (int m = 0; m < 32; ++m) oacc[m] *= srow[m];
        for (int kk = 0; kk < 32; ++kk) { const float v = Ks[kk * 321 + tid];
#pragma unroll
            for (int m = 0; m < 32; ++m) oacc[m] += Ps[m * 33 + kk] * v; }
        __syncthreads();
    }
#pragma unroll
    for (int m = 0; m < 32; ++m) { const int qi = m >> 2, h = m & 3; o_lat[((size_t)(rowq0 + qi) * 4 + h) * 256 + tid] = oacc[m] / lrow[m]; }
}
__global__ void k_convgate(const float* gate, const float* up, const float* state_conv, const float* conv_w, const float* conv_b, float* h, float* out) {
    const int gid = blockIdx.x * blockDim.x + threadIdx.x, nth = gridDim.x * blockDim.x;
    for (long i = gid; i < (long)R * D_FF; i += nth) { const int r = (int)(i / D_FF), f = (int)(i % D_FF);
        float g0, g1, g2 = gate[i];
        if (r < RP) { const int t = r % TP; g1 = t >= 1 ? gate[i - D_FF] : 0.f; g0 = t >= 2 ? gate[i - 2 * D_FF] : 0.f; }
        else { const int s = r - RP, db = s >> 3, t = s & 7;
            g1 = t >= 1 ? gate[i - D_FF] : state_conv[((size_t)db * 2 + 1) * D_FF + f];
            g0 = t >= 2 ? gate[i - 2 * D_FF] : state_conv[((size_t)db * 2 + t) * D_FF + f]; }
        const float c = conv_b[f] + conv_w[f] * g0 + conv_w[D_FF + f] * g1 + conv_w[2 * D_FF + f] * g2;
        h[i] = c / (1.0f + expf(-c)) * up[i];
        if (r < RP) { const int b = r / TP, t = r % TP; if (t >= TP - 2) out[O_CONVP + ((size_t)b * 2 + (t - (TP - 2))) * D_FF + f] = g2; }
        else { const int s = r - RP, db = s >> 3, t = s & 7; if (t >= 6) out[O_CONVS + ((size_t)db * 2 + (t - 6)) * D_FF + f] = g2; }
    }
}
__global__ void k_final(const float* x2, const float* g, float* out) {
    const int wave = (blockIdx.x * blockDim.x + threadIdx.x) >> 6, lane = threadIdx.x & 63, nw = (gridDim.x * blockDim.x) >> 6;
    for (int r = wave; r < R; r += nw) {
        float* dst;
        if (r < RP) { const int b = r / TP, t = r % TP; if (t < N_META) continue; dst = out + O_YP + ((size_t)b * SEQ + (t - N_META)) * D_MODEL; }
        else dst = out + O_YS + (size_t)(r - RP) * D_MODEL;
        float v[16]; float s = 0.f;
#pragma unroll
        for (int j = 0; j < 16; ++j) { v[j] = x2[(size_t)r * D_MODEL + lane + 64 * j]; s += v[j] * v[j]; }
        s = wsum(s); const float rs = 1.0f / sqrtf(s * (1.0f / D_MODEL) + EPS);
#pragma unroll
        for (int j = 0; j < 16; ++j) dst[lane + 64 * j] = v[j] * rs * g[lane + 64 * j];
    }
}

struct WS {
    float *rope_cos, *rope_sin, *abar_re, *abar_im, *bbar_re, *bbar_im;
    float *x0, *xn, *z, *cqn, *q, *q_lat, *q_rope, *ckv, *kr, *ys5a, *lin, *cat, *o_lat, *x1, *xn2, *gate, *up, *h, *x2;
};
inline WS carve(float* base) {
    WS w; float* p = base;
    auto take = [&](size_t n) { float* r = p; p += (n + 63) / 64 * 64; return r; };
    w.rope_cos = take((TP + 8) * 32); w.rope_sin = take((TP + 8) * 32); w.abar_re = take(2048); w.abar_im = take(2048); w.bbar_re = take(2048 * 16); w.bbar_im = take(2048 * 16);
    w.x0 = take((size_t)R * 1024); w.xn = take((size_t)R * 1024); w.z = take((size_t)R * IN_W); w.cqn = take((size_t)R * 384); w.q = take((size_t)R * 768);
    w.q_lat = take((size_t)R * 1024); w.q_rope = take((size_t)R * 256); w.ckv = take((size_t)R * 256); w.kr = take((size_t)R * 64); w.ys5a = take((size_t)R * 512);
    w.lin = take((size_t)R * 512); w.cat = take((size_t)R * 1024); w.o_lat = take((size_t)R * 1024); w.x1 = take((size_t)R * 1024); w.xn2 = take((size_t)R * 1024);
    w.gate = take((size_t)R * D_FF); w.up = take((size_t)R * D_FF); w.h = take((size_t)R * D_FF); w.x2 = take((size_t)R * 1024);
    return w;
}
constexpr size_t WS_FLOATS = (size_t)R * (1024 * 8 + IN_W + 384 + 768 + 256 + 256 + 64 + 512 + 512 + 3 * D_FF) + 400000;

inline void forward(void* const* d_in, float* out, const WS& w, hipStream_t st) {
    const float* x_prompt = (const float*)d_in[0]; const float* x_sample = (const float*)d_in[1]; const float* cache_ckv = (const float*)d_in[2]; const float* cache_kr = (const float*)d_in[3];
    const float* st_re = (const float*)d_in[4]; const float* st_im = (const float*)d_in[5]; const float* st_conv = (const float*)d_in[6]; const int* page_table = (const int*)d_in[7];
    const float* meta = (const float*)d_in[8]; const float* g_mix = (const float*)d_in[9]; const float* w_in = (const float*)d_in[10]; const float* g_q = (const float*)d_in[11];
    const float* w_uq = (const float*)d_in[12]; const float* g_kv = (const float*)d_in[13]; const float* w_uk = (const float*)d_in[14]; const float* w_uv = (const float*)d_in[15];
    const float* a_re = (const float*)d_in[16]; const float* a_im = (const float*)d_in[17]; const float* log_dt = (const float*)d_in[18]; const float* b_re = (const float*)d_in[19];
    const float* b_im = (const float*)d_in[20]; const float* c_re = (const float*)d_in[21]; const float* c_im = (const float*)d_in[22]; const float* s5_d = (const float*)d_in[23];
    const float* w_glu = (const float*)d_in[24]; const float* w_out = (const float*)d_in[25]; const float* g_ffn = (const float*)d_in[26]; const float* w_gate = (const float*)d_in[27];
    const float* w_up = (const float*)d_in[28]; const float* conv_w = (const float*)d_in[29]; const float* conv_b = (const float*)d_in[30]; const float* w_down = (const float*)d_in[31];
    const float* g_final = (const float*)d_in[32];
    k_setup<<<256, 256, 0, st>>>(w.rope_cos, w.rope_sin, a_re, a_im, log_dt, b_re, b_im, w.abar_re, w.abar_im, w.bbar_re, w.bbar_im);
    k_embed_norm<<<2048, 256, 0, st>>>(x_prompt, x_sample, meta, g_mix, w.x0, w.xn);
    gemm(st, w.xn, 1024, w_in, IN_W, 1, w.z, IN_W, nullptr, R, IN_W, 1024);
    k_rmsnorm<<<2048, 256, 0, st>>>(w.z + 512, IN_W, w.cqn, 384, g_q, 384, R);
    k_rmsnorm<<<2048, 256, 0, st>>>(w.z + 896, IN_W, w.ckv, 256, g_kv, 256, R);
    k_rope<<<2048, 256, 0, st>>>(w.z + 1152, IN_W, 0, w.kr, 64, 1, w.rope_cos, w.rope_sin);
    k_rows_out<<<2048, 256, 0, st>>>(w.ckv, 256, out + O_CKVP, out + O_CKVS);
    k_rows_out<<<2048, 256, 0, st>>>(w.kr, 64, out + O_KRP, out + O_KRS);
    gemm(st, w.cqn, 384, w_uq, 768, 1, w.q, 768, nullptr, R, 768, 384);
    for (int h = 0; h < 4; ++h) gemm(st, w.q + h * 192, 768, w_uk + h * 128, 1, 512, w.q_lat + h * 256, 1024, nullptr, R, 256, 128);
    k_rope<<<2048, 256, 0, st>>>(w.q + 128, 768, 192, w.q_rope, 256, 4, w.rope_cos, w.rope_sin);
    k_s5<<<(BATCH + DEC_BATCH) * S5_GROUPS, 64, 0, st>>>(w.z, w.abar_re, w.abar_im, w.bbar_re, w.bbar_im, c_re, c_im, s5_d, st_re, st_im, w.ys5a, out);
    gemm(st, w.ys5a, 512, w_glu, 512, 1, w.lin, 512, nullptr, R, 512, 512);
    k_glu<<<2048, 256, 0, st>>>(w.ys5a, w.lin, w.cat);
    k_attn<<<BATCH * 514 + DEC_BATCH, 256, ATT_LDS_FLOATS * 4, st>>>(w.q_lat, w.q_rope, w.ckv, w.kr, cache_ckv, cache_kr, page_table, w.o_lat);
    for (int h = 0; h < 4; ++h) gemm(st, w.o_lat + h * 256, 1024, w_uv + h * 128, 512, 1, w.cat + 512 + h * 128, 1024, nullptr, R, 128, 256);
    gemm(st, w.cat, 1024, w_out, 1024, 1, w.x1, 1024, w.x0, R, 1024, 1024);
    k_rmsnorm<<<2048, 256, 0, st>>>(w.x1, 1024, w.xn2, 1024, g_ffn, 1024, R);
    gemm(st, w.xn2, 1024, w_gate, D_FF, 1, w.gate, D_FF, nullptr, R, D_FF, 1024);
    gemm(st, w.xn2, 1024, w_up, D_FF, 1, w.up, D_FF, nullptr, R, D_FF, 1024);
    k_convgate<<<4096, 256, 0, st>>>(w.gate, w.up, st_conv, conv_w, conv_b, w.h, out);
    gemm(st, w.h, D_FF, w_down, 1024, 1, w.x2, 1024, w.x1, R, 1024, D_FF);
    k_final<<<2048, 256, 0, st>>>(w.x2, g_final, out);
}
}
#define GAS __attribute__((address_space(1)))
#define LAS __attribute__((address_space(3)))
typedef unsigned short bf16;
typedef unsigned v4u __attribute__((ext_vector_type(4)));
typedef float f32x4 __attribute__((ext_vector_type(4)));
typedef short bf16x8 __attribute__((ext_vector_type(8)));
typedef GAS unsigned gu32;
typedef GAS unsigned long long gu64;
#define RLX_AGENT __ATOMIC_RELAXED, __HIP_MEMORY_SCOPE_AGENT
#define LDS_WAIT() asm volatile("s_waitcnt lgkmcnt(0)" ::: "memory")
#define VM_WAIT() asm volatile("s_waitcnt vmcnt(0)" ::: "memory")
__device__ __forceinline__ unsigned long long rt() { return __builtin_amdgcn_s_memrealtime(); }
__device__ __forceinline__ unsigned f2bf(float f) { unsigned u = __builtin_bit_cast(unsigned, f); return (u + 0x7fffu + ((u >> 16) & 1u)) >> 16; }
__device__ __forceinline__ unsigned pk2(float lo, float hi) { return f2bf(lo) | (f2bf(hi) << 16); }

#define XB_TMO      128
#define XB_XCNT(j)  (256  + 64 * (j))
#define XB_XSUB(j)  (1280 + 64 * (j))
#define XB_XGEN(j)  (2304 + 64 * (j))
#define XB_TOP      3328
#define XB_TOPGEN   3392
#define XCD_BAR_WORDS 3456
#define XB_SPIN_CAP (1u << 18)

__device__ __forceinline__ unsigned xb_ld(unsigned* p)              { return __hip_atomic_load(p, __ATOMIC_RELAXED, __HIP_MEMORY_SCOPE_AGENT); }
__device__ __forceinline__ unsigned xb_add(unsigned* p, unsigned v) { return __hip_atomic_fetch_add(p, v, __ATOMIC_RELAXED, __HIP_MEMORY_SCOPE_AGENT); }
__device__ __forceinline__ unsigned xb_xcc_id() { return (unsigned)__builtin_amdgcn_s_getreg((3 << 11) | 20) & 0xFu; }
#define XB_SPIN(cond, bar) do { unsigned _sp = 0; while (cond) { __builtin_amdgcn_s_sleep(1); \
    if ((++_sp & 255u) == 0u) { if (xb_ld(&(bar)[XB_TMO])) break; if (_sp > XB_SPIN_CAP) { atomicAdd(&(bar)[XB_TMO], 1u); break; } } } } while (0)

struct XcdBarrier {
    unsigned* bar; unsigned x;
    volatile LAS unsigned* st;
};

__device__ __forceinline__ XcdBarrier xcd_barrier_post(unsigned* bar, volatile LAS unsigned* st) {
    XcdBarrier b; b.bar = bar; b.x = xb_xcc_id(); b.st = st;
    if (threadIdx.x == 0) (void)xb_add(&bar[XB_XCNT(b.x)], 1u);
    return b;
}
__device__ __forceinline__ void xcd_barrier_complete(unsigned* bar, unsigned x, unsigned& nloc, unsigned& nx) {
    const unsigned G = gridDim.x * gridDim.y * gridDim.z;
    unsigned sum, cnt, mine, sp = 0u;
    for (;;) {
        sum = 0u; cnt = 0u; mine = 0u;
#pragma unroll
        for (unsigned j = 0; j < 16; ++j) { const unsigned c = xb_ld(&bar[XB_XCNT(j)]); sum += c; cnt += (c > 0u) ? 1u : 0u; mine = (j == x) ? c : mine; }
        if (sum == G) break;
        __builtin_amdgcn_s_sleep(1);
        if ((++sp & 255u) == 0u) { if (xb_ld(&bar[XB_TMO])) break; if (sp > XB_SPIN_CAP) { atomicAdd(&bar[XB_TMO], 1u); break; } }
    }
    nloc = mine > 0u ? mine : 1u; nx = cnt > 0u ? cnt : 1u;
}

__device__ __forceinline__ void xcd_barrier(const XcdBarrier& b) {
    asm volatile("s_waitcnt vmcnt(0)" ::: "memory");
    __syncthreads();
    if (threadIdx.x == 0) {
        unsigned* bar = b.bar;
        __builtin_amdgcn_s_waitcnt(0);
        unsigned nloc = b.st[0], nx = b.st[1];
        if (nloc == 0u) { xcd_barrier_complete(bar, b.x, nloc, nx); b.st[0] = nloc; b.st[1] = nx; }
        const unsigned old = xb_add(&bar[XB_XSUB(b.x)], 1u);
        const unsigned gen = old / nloc;
        if (old + 1u == (gen + 1u) * nloc) {
            __builtin_amdgcn_fence(__ATOMIC_RELEASE, "agent");
            asm volatile("s_waitcnt vmcnt(0)" ::: "memory");
            const unsigned og = xb_add(&bar[XB_TOP], 1u);
            const unsigned tg = og / nx;
            if (og + 1u == (tg + 1u) * nx) xb_add(&bar[XB_TOPGEN], 1u);
            else XB_SPIN(xb_ld(&bar[XB_TOPGEN]) == tg, bar);
            __builtin_amdgcn_fence(__ATOMIC_ACQUIRE, "agent");
            xb_add(&bar[XB_XGEN(b.x)], 1u);
            asm volatile("s_waitcnt vmcnt(0)" ::: "memory");
        } else {
            XB_SPIN(xb_ld(&bar[XB_XGEN(b.x)]) == gen, bar);
            __builtin_amdgcn_fence(__ATOMIC_ACQUIRE, "agent");
            asm volatile("s_waitcnt vmcnt(0)" ::: "memory");
        }
    }
    __syncthreads();
}
namespace pg8 {
#define PG8_LAS __attribute__((address_space(3)))
typedef unsigned short bf16_t;
typedef short bf16x8 __attribute__((ext_vector_type(8)));
typedef float f32x4 __attribute__((ext_vector_type(4)));
typedef unsigned u32x4 __attribute__((ext_vector_type(4)));
constexpr int BM = 256, BK = 64, HALF = 128, HTB = HALF * BK * 2  , STAGE_BYTES = 8 * HTB, NXCD = 8, WGM = 8;

__host__ __device__ __forceinline__ int lds_byte(int r, int c) { const int st = (r >> 4) * 2 + (c >> 5), rr = r & 15, cc = c & 31, ob = rr * 64 + cc * 2; return st * 1024 + (ob ^ (((ob >> 9) & 1) << 5)); }
__host__ __device__ __forceinline__ void stage_rc(int b, int& R, int& C) { const int st = b / 1024, sb = b % 1024, swz = sb ^ (((sb >> 9) & 1) << 5); R = (st >> 1) * 16 + swz / 64; C = (st & 1) * 32 + (swz % 64) / 2; }
__host__ __device__ __forceinline__ int perm32(int rho) { const int n = rho >> 4, i = rho & 15; return 8 * (i >> 2) + 4 * n + (i & 3); }

struct Unit { int pm, pn; };
struct Gemm { const bf16_t* A; const bf16_t* Bt; int M, N, K; };

struct StaticOrder {
    int nM, nN, nwg, G, c;
    __host__ __device__ void init(int M, int N, int G_, int c_) { nM = M / BM; nN = N / BM; nwg = nM * nN; G = G_; c = c_; }
    __host__ __device__ bool next(int i, Unit& u) const {
        const long L = (long)i * G + c; if (L >= nwg) return false;
        int wgid = (int)L; { const int q = nwg / NXCD, r = nwg % NXCD, xcd = wgid % NXCD, off = wgid / NXCD; wgid = (xcd < r ? xcd * (q + 1) : r * (q + 1) + (xcd - r) * q) + off; }
        const int nig = WGM * nN, gid = wgid / nig, fm = gid * WGM, gsz = (nM - fm) < WGM ? (nM - fm) : WGM;
        u.pm = fm + ((wgid % nig) % gsz); u.pn = (wgid % nig) / gsz; return true;
    }
    __device__ __forceinline__ void a_ready(const Unit&) const {}
    __device__ __forceinline__ void done(const Unit&) const {}
};

__device__ __forceinline__ unsigned cvt_pk_bf16(float lo, float hi) { unsigned r; asm volatile("v_cvt_pk_bf16_f32 %0, %1, %2" : "=v"(r) : "v"(lo), "v"(hi)); return r; }
typedef float f32x2 __attribute__((ext_vector_type(2)));
__device__ __forceinline__ f32x2 gelu_pk(f32x2 v) {
    const f32x2 av = __builtin_elementwise_abs(v), d = av * 0.2316418882f + 1.0f;
    f32x2 t; t.x = __builtin_amdgcn_rcpf(d.x); t.y = __builtin_amdgcn_rcpf(d.y);
    f32x2 q = t * 0.5307027145f + (-0.7265760135f); q = q * t + 0.7107068705f; q = q * t + (-0.142248368f); q = q * t + 0.127414796f; q = q * t;
    const f32x2 s = (v * v) * (-0.72134752044f);
    f32x2 e; e.x = __builtin_amdgcn_exp2f(s.x); e.y = __builtin_amdgcn_exp2f(s.y);
    const f32x2 m = v * (q * e), r = v - m;
    f32x2 o; o.x = v.x < 0.f ? m.x : r.x; o.y = v.y < 0.f ? m.y : r.y; return o;
}

template <int ACT  > struct EpiBf16 {
    static constexpr bool PERM = true, AFTER_DRAIN = false; static_assert(ACT == 0 || ACT == 1, "EpiBf16: ACT is 0 (none) or 1 (gelu_pk)");
    bf16_t* O; int ldc; const float* bias; int split_cols; size_t split_stride; float scale0;
    __device__ __forceinline__ void operator()(const f32x4 (&acc)[2][2][4][2], const Unit& u, int wr, int wc, int fr, int fq) const {
        const int row0 = u.pm * BM + wr * 64 + fr; int colt = u.pn * BM; bf16_t* base = O;
        float sc = 1.f; if (split_cols) { const int t = colt / split_cols; base += (size_t)t * split_stride; colt -= t * split_cols; if (t == 0) sc = scale0; }
        const int col0 = colt + wc * 32 + 8 * fq, bcol0 = u.pn * BM + wc * 32 + 8 * fq;
        f32x4 bv[2][2];
#pragma unroll
        for (int bj = 0; bj < 2; ++bj)
#pragma unroll
            for (int n = 0; n < 2; ++n) bv[bj][n] = bias ? *(const f32x4*)(bias + bcol0 + bj * HALF + 4 * n) : (f32x4){0.f, 0.f, 0.f, 0.f};
#pragma unroll
        for (int ai = 0; ai < 2; ++ai)
#pragma unroll
            for (int m = 0; m < 4; ++m) { bf16_t* rowp = base + (size_t)(row0 + ai * HALF + m * 16) * ldc + col0;
#pragma unroll
                for (int bj = 0; bj < 2; ++bj) { f32x4 v0 = acc[ai][bj][m][0] + bv[bj][0], v1 = acc[ai][bj][m][1] + bv[bj][1];
                    if (ACT == 1) { f32x2 a = gelu_pk((f32x2){v0[0], v0[1]}), b = gelu_pk((f32x2){v0[2], v0[3]}), c = gelu_pk((f32x2){v1[0], v1[1]}), d = gelu_pk((f32x2){v1[2], v1[3]});
                        v0 = (f32x4){a.x, a.y, b.x, b.y}; v1 = (f32x4){c.x, c.y, d.x, d.y}; }
                    v0 = v0 * sc; v1 = v1 * sc; u32x4 w; w.x = cvt_pk_bf16(v0[0], v0[1]); w.y = cvt_pk_bf16(v0[2], v0[3]); w.z = cvt_pk_bf16(v1[0], v1[1]); w.w = cvt_pk_bf16(v1[2], v1[3]);
                    *(u32x4*)(rowp + bj * HALF) = w; } }
    }
};
template <class Epi, class Sched, bool ALIGN_EPI = false, bool SP2 = false>
__device__ __forceinline__ void gemm_phase(PG8_LAS unsigned char* lds, const Gemm g, const Sched& S, const Epi& E) {
    const int tid = threadIdx.x, wid = __builtin_amdgcn_readfirstlane(tid >> 6), lane = tid & 63, wr = wid >> 2, wc = wid & 3, fr = lane & 15, fq = lane >> 4;
    const int K = g.K, nt = K / BK;
    unsigned voffA[2], voffB[2];
#pragma unroll
    for (int i = 0; i < 2; ++i) { int R, C; stage_rc(tid * 16 + i * 8192, R, C); const int Rb = Epi::PERM ? ((R & ~31) + perm32(R & 31)) : R;
        voffA[i] = (unsigned)(R * K + C) * 2u; voffB[i] = (unsigned)(Rb * K + C) * 2u; }
    const size_t kstep = (size_t)(BK * 2);
    const size_t hstep = (size_t)HALF * K * 2;
    const size_t tstep = 2 * hstep;
    const unsigned ldsw = (unsigned)wid * 1024u;
    const int aoff = lds_byte(wr * 64 + fr, fq * 8), boff = lds_byte(wc * 32 + fr, fq * 8);
#define PG8_SA(b, h) (((b) * 2 + (h)) * HTB)
#define PG8_SB(b, h) ((4 + (b) * 2 + (h)) * HTB)
#define PG8_STAGE(bufoff, gbase, voff) do { _Pragma("unroll") for (int _i = 0; _i < 2; ++_i) \
        __builtin_amdgcn_global_load_lds((const unsigned*)((const char*)(gbase) + (voff)[_i]), (PG8_LAS unsigned*)(lds + (bufoff) + ldsw + _i * 8192), 16, 0, 0); } while (0)
#define PG8_LDA(dst, b, h) do { _Pragma("unroll") for (int m = 0; m < 4; ++m) _Pragma("unroll") for (int k = 0; k < 2; ++k) dst[m][k] = *(const PG8_LAS bf16x8*)(lds + PG8_SA(b, h) + aoff + m * 2048 + k * 1024); } while (0)
#define PG8_LDB(dst, b, h) do { _Pragma("unroll") for (int n = 0; n < 2; ++n) _Pragma("unroll") for (int k = 0; k < 2; ++k) dst[n][k] = *(const PG8_LAS bf16x8*)(lds + PG8_SB(b, h) + boff + n * 2048 + k * 1024); } while (0)
#define PG8_MMA(ai, bj, At, Bt) do { __builtin_amdgcn_s_setprio(1); _Pragma("unroll") for (int m = 0; m < 4; ++m) _Pragma("unroll") for (int n = 0; n < 2; ++n) _Pragma("unroll") for (int k = 0; k < 2; ++k) \
        acc[ai][bj][m][n] = __builtin_amdgcn_mfma_f32_16x16x32_bf16(Bt[n][k], At[m][k], acc[ai][bj][m][n], 0, 0, 0); __builtin_amdgcn_s_setprio(0); } while (0)
#define PG8_WAIT_V(n) asm volatile("s_waitcnt vmcnt(" #n ")" ::: "memory")
#define PG8_WAIT_L(n) asm volatile("s_waitcnt lgkmcnt(" #n ")" ::: "memory")
#define PG8_BAR __builtin_amdgcn_s_barrier()
#define PG8_SCHED __builtin_amdgcn_sched_barrier(0)
    Unit cur, nxt; int ui = 0;
    if (!S.next(0, cur)) return;
    f32x4 acc[2][2][4][2];
#pragma unroll
    for (int a = 0; a < 2; ++a)
#pragma unroll
        for (int b = 0; b < 2; ++b)
#pragma unroll
            for (int m = 0; m < 4; ++m)
#pragma unroll
                for (int n = 0; n < 2; ++n) acc[a][b][m][n] = (f32x4){0.f, 0.f, 0.f, 0.f};
    bf16x8 At[4][2], B0[2][2], B1[2][2];
    const char* cA = (const char*)g.A + (size_t)cur.pm * tstep; const char* cB = (const char*)g.Bt + (size_t)cur.pn * tstep;
    S.a_ready(cur);
    if constexpr (SP2) {
        PG8_STAGE(PG8_SB(0, 0), cB, voffB); PG8_STAGE(PG8_SB(0, 1), cB + hstep, voffB); PG8_STAGE(PG8_SA(0, 0), cA, voffA); PG8_STAGE(PG8_SA(0, 1), cA + hstep, voffA);
        if (wr == 1) PG8_BAR;
        PG8_WAIT_V(2); PG8_BAR;
        PG8_STAGE(PG8_SB(1, 0), cB + kstep, voffB); PG8_STAGE(PG8_SA(1, 0), cA + kstep, voffA); PG8_STAGE(PG8_SB(1, 1), cB + hstep + kstep, voffB);
        PG8_WAIT_V(6); PG8_BAR;
    } else {
        PG8_STAGE(PG8_SB(0, 0), cB, voffB); PG8_STAGE(PG8_SA(0, 0), cA, voffA); PG8_STAGE(PG8_SB(0, 1), cB + hstep, voffB); PG8_STAGE(PG8_SA(0, 1), cA + hstep, voffA);
        if (wr == 1) PG8_BAR;
        PG8_WAIT_V(4); PG8_BAR;
        PG8_STAGE(PG8_SB(1, 0), cB + kstep, voffB); PG8_STAGE(PG8_SA(1, 0), cA + kstep, voffA); PG8_STAGE(PG8_SB(1, 1), cB + hstep + kstep, voffB);
        PG8_WAIT_V(6); PG8_BAR;
    }
    for (;;) {
        const bool has_next = S.next(ui + 1, nxt);
        const char* nA = has_next ? (const char*)g.A + (size_t)nxt.pm * tstep : cA; const char* nB = has_next ? (const char*)g.Bt + (size_t)nxt.pn * tstep : cB;
        for (int t = 0; t < nt; t += 2) {
            const bool last = (t == nt - 2);
            const char* a1 = cA + (size_t)(t + 1) * kstep;
            const char* a2 = last ? nA : cA + (size_t)(t + 2) * kstep; const char* b2 = last ? nB : cB + (size_t)(t + 2) * kstep;
            const char* a3 = a2 + kstep; const char* b3 = b2 + kstep;
            if (last && has_next) S.a_ready(nxt);
            if constexpr (SP2) {
            PG8_LDB(B0, 0, 0); PG8_LDB(B1, 0, 1); PG8_SCHED; PG8_LDA(At, 0, 0); PG8_STAGE(PG8_SA(1, 1), a1 + hstep, voffA);
            PG8_WAIT_V(8); PG8_WAIT_L(0); PG8_BAR; PG8_MMA(0, 0, At, B0); PG8_MMA(0, 1, At, B1); PG8_BAR; PG8_SCHED;
            PG8_LDA(At, 0, 1); PG8_STAGE(PG8_SB(0, 0), b2, voffB); PG8_STAGE(PG8_SB(0, 1), b2 + hstep, voffB); PG8_STAGE(PG8_SA(0, 0), a2, voffA);
            PG8_WAIT_V(8); PG8_WAIT_L(0); PG8_BAR; PG8_MMA(1, 0, At, B0); PG8_MMA(1, 1, At, B1); PG8_BAR; PG8_SCHED;
            PG8_LDB(B0, 1, 0); PG8_LDB(B1, 1, 1); PG8_SCHED; PG8_LDA(At, 1, 0); PG8_STAGE(PG8_SA(0, 1), a2 + hstep, voffA);
            PG8_WAIT_V(8); PG8_WAIT_L(0); PG8_BAR; PG8_MMA(0, 0, At, B0); PG8_MMA(0, 1, At, B1); PG8_BAR; PG8_SCHED;
            PG8_LDA(At, 1, 1); PG8_STAGE(PG8_SB(1, 0), b3, voffB); PG8_STAGE(PG8_SB(1, 1), b3 + hstep, voffB); PG8_STAGE(PG8_SA(1, 0), a3, voffA);
            PG8_WAIT_V(8); PG8_WAIT_L(0); PG8_BAR; PG8_MMA(1, 0, At, B0); PG8_MMA(1, 1, At, B1); PG8_BAR; PG8_SCHED;
            } else {
            PG8_LDB(B0, 0, 0); PG8_SCHED; PG8_LDA(At, 0, 0); PG8_STAGE(PG8_SA(1, 1), a1 + hstep, voffA);
            PG8_WAIT_L(8); PG8_BAR; PG8_WAIT_L(0); PG8_MMA(0, 0, At, B0); PG8_BAR; PG8_SCHED;
            PG8_LDB(B1, 0, 1); PG8_STAGE(PG8_SB(0, 0), b2, voffB);
            PG8_BAR; PG8_WAIT_L(0); PG8_MMA(0, 1, At, B1); PG8_BAR;
            PG8_LDA(At, 0, 1); PG8_STAGE(PG8_SA(0, 0), a2, voffA);
            PG8_BAR; PG8_WAIT_L(0); PG8_MMA(1, 0, At, B0); PG8_BAR; PG8_SCHED;
            PG8_STAGE(PG8_SB(0, 1), b2 + hstep, voffB);
            PG8_WAIT_V(6); PG8_BAR; PG8_MMA(1, 1, At, B1); PG8_BAR;
            PG8_LDB(B0, 1, 0); PG8_SCHED; PG8_LDA(At, 1, 0); PG8_STAGE(PG8_SA(0, 1), a2 + hstep, voffA);
            PG8_WAIT_L(8); PG8_BAR; PG8_WAIT_L(0); PG8_MMA(0, 0, At, B0); PG8_BAR; PG8_SCHED;
            PG8_LDB(B1, 1, 1); PG8_STAGE(PG8_SB(1, 0), b3, voffB);
            PG8_BAR; PG8_WAIT_L(0); PG8_MMA(0, 1, At, B1); PG8_BAR;
            PG8_LDA(At, 1, 1); PG8_STAGE(PG8_SA(1, 0), a3, voffA);
            PG8_BAR; PG8_WAIT_L(0); PG8_MMA(1, 0, At, B0); PG8_BAR; PG8_SCHED;
            PG8_STAGE(PG8_SB(1, 1), b3 + hstep, voffB);
            PG8_WAIT_V(6); PG8_BAR; PG8_MMA(1, 1, At, B1); PG8_BAR;
            }
        }
        if constexpr (ALIGN_EPI) { if (wr == 0) PG8_BAR; }
        if constexpr (!Epi::AFTER_DRAIN) { E(acc, cur, wr, wc, fr, fq); S.done(cur); }
        if (!has_next) break;
#pragma unroll
        for (int a = 0; a < 2; ++a)
#pragma unroll
            for (int b = 0; b < 2; ++b)
#pragma unroll
                for (int m = 0; m < 4; ++m)
#pragma unroll
                    for (int n = 0; n < 2; ++n) acc[a][b][m][n] = (f32x4){0.f, 0.f, 0.f, 0.f};
        cur = nxt; cA = nA; cB = nB; ++ui;
        if constexpr (ALIGN_EPI) { if (wr == 1) PG8_BAR; }
    }
    PG8_WAIT_V(0);
    if constexpr (!ALIGN_EPI) { if (wr == 0) PG8_BAR; }
    PG8_BAR;
    if constexpr (Epi::AFTER_DRAIN) { E.fused(acc, cur, wr, wc, fr, fq, lds, wid, lane); S.done(cur); }
#undef PG8_SA
#undef PG8_SB
#undef PG8_STAGE
#undef PG8_LDA
#undef PG8_LDB
#undef PG8_MMA
#undef PG8_WAIT_V
#undef PG8_WAIT_L
#undef PG8_BAR
#undef PG8_SCHED
}
}
namespace fk {
using pg8::bf16_t; using pg8::f32x4; using pg8::u32x4; using pg8::Unit;
typedef unsigned u32x2 __attribute__((ext_vector_type(2)));
constexpr int MP = 17664;
constexpr int FR_META = 16384, FR_SAMP = 16640;
constexpr int TPK = nv::TP;
constexpr float EPS = 1e-6f;
constexpr float C2Q = 0.07216878364870322f * 1.4426950408889634f;
constexpr int NTHREADS = 512, NWAVES = 8;

struct P {
    const float *x_prompt, *x_sample, *cache_ckv, *cache_kr, *st_re, *st_im, *st_conv; const int* page_table;
    const float *meta, *g_mix, *w_in, *g_q, *w_uq, *g_kv, *w_uk, *w_uv, *a_re, *a_im, *log_dt, *b_re, *b_im, *c_re, *c_im, *s5_d, *w_glu, *w_out, *g_ffn, *w_gate, *w_up, *conv_w, *conv_b, *w_down, *g_final;
    float* out;
    unsigned* ctl;
    bf16_t *Bt_in, *Bt_uq, *Bt_kv, *Bt_glu, *Bt_out, *Bt_gu, *Bt_down;
    float *rope_cos, *rope_sin, *abar_re, *abar_im, *bbar_re, *bbar_im;
    bf16_t *XN, *U, *CQ, *CKVB, *QB, *KB, *VB, *YS, *CAT, *X1B, *H, *UPB;
    float *CKVF, *SSQKV, *SSQQ, *X1, *SSQ1, *GATE, *X2, *APART;
};
struct Carver { char* p; template <class T> T* take(size_t n) { T* r = (T*)p; p += (n * sizeof(T) + 255) / 256 * 256; return r; } };
inline void carve(P& q, char* base) {
    Carver c{base};
    q.ctl = c.take<unsigned>(1 << 18);
    q.Bt_in = c.take<bf16_t>((size_t)1280 * 1024); q.Bt_uq = c.take<bf16_t>((size_t)768 * 384); q.Bt_kv = c.take<bf16_t>((size_t)1024 * 256);
    q.Bt_glu = c.take<bf16_t>((size_t)512 * 512); q.Bt_out = c.take<bf16_t>((size_t)1024 * 1024); q.Bt_gu = c.take<bf16_t>((size_t)5632 * 1024); q.Bt_down = c.take<bf16_t>((size_t)1024 * 2816);
    q.rope_cos = c.take<float>(4120 * 32); q.rope_sin = c.take<float>(4120 * 32); q.abar_re = c.take<float>(2048); q.abar_im = c.take<float>(2048); q.bbar_re = c.take<float>(32768); q.bbar_im = c.take<float>(32768);
    q.XN = c.take<bf16_t>((size_t)MP * 1024); q.U = c.take<bf16_t>((size_t)MP * 512); q.CQ = c.take<bf16_t>((size_t)MP * 384); q.CKVB = c.take<bf16_t>((size_t)MP * 256);
    q.QB = c.take<bf16_t>((size_t)MP * 768); q.KB = c.take<bf16_t>((size_t)MP * 768); q.VB = c.take<bf16_t>((size_t)MP * 512); q.YS = c.take<bf16_t>((size_t)MP * 512);
    q.CAT = c.take<bf16_t>((size_t)MP * 1024); q.X1B = c.take<bf16_t>((size_t)MP * 1024); q.H = c.take<bf16_t>((size_t)MP * 2816); q.UPB = c.take<bf16_t>((size_t)MP * 2816);
    q.CKVF = c.take<float>((size_t)MP * 256); q.SSQKV = c.take<float>((size_t)MP * 4); q.SSQQ = c.take<float>((size_t)MP * 8); q.X1 = c.take<float>((size_t)MP * 1024);
    q.SSQ1 = c.take<float>((size_t)MP * 16); q.GATE = c.take<float>((size_t)MP * 2816); q.X2 = c.take<float>((size_t)MP * 1024); q.APART = c.take<float>((size_t)256 * (32 * 256 + 64));
}
inline void fill_inputs(P& q, void* const* d_in, float* out) {
    q.x_prompt = (const float*)d_in[0]; q.x_sample = (const float*)d_in[1]; q.cache_ckv = (const float*)d_in[2]; q.cache_kr = (const float*)d_in[3];
    q.st_re = (const float*)d_in[4]; q.st_im = (const float*)d_in[5]; q.st_conv = (const float*)d_in[6]; q.page_table = (const int*)d_in[7];
    q.meta = (const float*)d_in[8]; q.g_mix = (const float*)d_in[9]; q.w_in = (const float*)d_in[10]; q.g_q = (const float*)d_in[11];
    q.w_uq = (const float*)d_in[12]; q.g_kv = (const float*)d_in[13]; q.w_uk = (const float*)d_in[14]; q.w_uv = (const float*)d_in[15];
    q.a_re = (const float*)d_in[16]; q.a_im = (const float*)d_in[17]; q.log_dt = (const float*)d_in[18]; q.b_re = (const float*)d_in[19];
    q.b_im = (const float*)d_in[20]; q.c_re = (const float*)d_in[21]; q.c_im = (const float*)d_in[22]; q.s5_d = (const float*)d_in[23];
    q.w_glu = (const float*)d_in[24]; q.w_out = (const float*)d_in[25]; q.g_ffn = (const float*)d_in[26]; q.w_gate = (const float*)d_in[27];
    q.w_up = (const float*)d_in[28]; q.conv_w = (const float*)d_in[29]; q.conv_b = (const float*)d_in[30]; q.w_down = (const float*)d_in[31];
    q.g_final = (const float*)d_in[32]; q.out = out;
}

__device__ __forceinline__ int fr_posidx(int fr) { return fr < FR_META ? (fr & 4095) + 16 : (fr < FR_SAMP ? (fr - FR_META) & 15 : TPK + ((fr - FR_SAMP) & 7)); }
__device__ __forceinline__ unsigned pk2(float lo, float hi) { return pg8::cvt_pk_bf16(lo, hi); }
__device__ __forceinline__ float bf2f(bf16_t v) { return __uint_as_float((unsigned)v << 16); }
__device__ __forceinline__ float wsum(float v) {
#pragma unroll
    for (int o = 1; o < 64; o <<= 1) v += __shfl_xor(v, o);
    return v;
}

__device__ __forceinline__ void conv_item(const float* W, int ldw, int c0, const float* gk, int k0, bf16_t* Bt, int K, int n0, LAS float* scr, int lane) {
#pragma unroll 8
    for (int i = 0; i < 32; ++i) { const int kk = 2 * i + (lane >> 5); float v = 0.f;
        if (c0 >= 0) { v = W[(size_t)(k0 + kk) * ldw + c0 + (lane & 31)]; if (gk) v *= gk[k0 + kk]; }
        scr[kk * 33 + (lane & 31)] = v; }
    LDS_WAIT(); asm volatile("" ::: "memory");
    const int c = lane & 7;
#pragma unroll
    for (int j = 0; j < 4; ++j) { const int n = (lane >> 3) + 8 * j; const LAS float* s = scr + (8 * c) * 33 + n;
        v4u o; o.x = pk2(s[0 * 33], s[1 * 33]); o.y = pk2(s[2 * 33], s[3 * 33]); o.z = pk2(s[4 * 33], s[5 * 33]); o.w = pk2(s[6 * 33], s[7 * 33]);
        *(GAS v4u*)(Bt + (size_t)(n0 + n) * K + k0 + 8 * c) = o; }
    LDS_WAIT(); asm volatile("" ::: "memory");
}
__device__ __forceinline__ int in_colmap(int nb) {
    if (nb < 16) return 32 * nb;
    if (nb < 24) return 896 + 32 * (nb - 16);
    if (nb < 32) return 512 + 32 * (nb - 24);
    if (nb == 32) return 1152;
    if (nb < 36) return 768 + 32 * (nb - 33);
    if (nb == 36) return 1184;
    if (nb == 37) return 864;
    return -1;
}
__device__ __forceinline__ int uq_colmap(int nb) {
    if (nb < 16) return 192 * (nb >> 2) + 32 * (nb & 3);
    if (nb < 20) return 192 * (nb - 16) + 128;
    return 192 * (nb - 20) + 160;
}
constexpr int IT_IN = 40 * 16, IT_UQ = 24 * 6, IT_KV = 32 * 4, IT_GLU = 16 * 8, IT_OUT = 32 * 16, IT_GU = 176 * 16, IT_DN = 32 * 44;
constexpr int IT_TOTAL = IT_IN + IT_UQ + IT_KV + IT_GLU + IT_OUT + IT_GU + IT_DN;
__device__ __forceinline__ void prologue(const P& p, LAS unsigned char* lds, int vcu, int G) {
    const int tid = threadIdx.x, lane = tid & 63, wave = tid >> 6;
    LAS float* scr = (LAS float*)(lds + wave * 16384);
    const int gw = vcu * NWAVES + wave, NGW = G * NWAVES;
    for (int it = gw; it < IT_TOTAL; it += NGW) {
        int r = it;
        if (r < IT_IN) { const int nb = r % 40, kb = r / 40; conv_item(p.w_in, 1216, in_colmap(nb), nullptr, 64 * kb, p.Bt_in, 1024, 32 * nb, scr, lane); continue; } r -= IT_IN;
        if (r < IT_UQ) { const int nb = r % 24, kb = r / 24; conv_item(p.w_uq, 768, uq_colmap(nb), p.g_q, 64 * kb, p.Bt_uq, 384, 32 * nb, scr, lane); continue; } r -= IT_UQ;
        if (r < IT_KV) { const int nb = r % 32, kb = r / 32; conv_item(nb < 16 ? p.w_uk : p.w_uv, 512, 32 * (nb & 15), p.g_kv, 64 * kb, p.Bt_kv, 256, 32 * nb, scr, lane); continue; } r -= IT_KV;
        if (r < IT_GLU) { const int nb = r % 16, kb = r / 16; conv_item(p.w_glu, 512, 32 * nb, nullptr, 64 * kb, p.Bt_glu, 512, 32 * nb, scr, lane); continue; } r -= IT_GLU;
        if (r < IT_OUT) { const int nb = r % 32, kb = r / 32; conv_item(p.w_out, 1024, 32 * nb, nullptr, 64 * kb, p.Bt_out, 1024, 32 * nb, scr, lane); continue; } r -= IT_OUT;
        if (r < IT_GU) { const int nb = r % 176, kb = r / 176, pn = nb >> 3, nl = nb & 7;
            conv_item(nl < 4 ? p.w_gate : p.w_up, 2816, 128 * pn + 32 * (nl & 3), p.g_ffn, 64 * kb, p.Bt_gu, 1024, 32 * nb, scr, lane); continue; } r -= IT_GU;
        { const int nb = r % 32, kb = r / 32; conv_item(p.w_down, 1024, 32 * nb, nullptr, 64 * kb, p.Bt_down, 2816, 32 * nb, scr, lane); }
    }
    for (int fr = gw; fr < MP; fr += NGW) {
        const float* src = nullptr;
        if (fr < FR_META) src = p.x_prompt + (size_t)fr * 1024;
        else if (fr < FR_META + 16) src = p.meta + (size_t)(fr - FR_META) * 1024;
        else if (fr >= FR_SAMP) src = p.x_sample + (size_t)(fr - FR_SAMP) * 1024;
        GAS unsigned long long* o8 = (GAS unsigned long long*)(p.XN + (size_t)fr * 1024) + lane;
        if (!src) {
#pragma unroll
            for (int j = 0; j < 4; ++j) o8[64 * j] = 0ull;
            continue; }
        const GAS f32x4* xr = (const GAS f32x4*)src + lane; const GAS f32x4* gr = (const GAS f32x4*)p.g_mix + lane;
        f32x4 v[4]; float s = 0.f;
#pragma unroll
        for (int j = 0; j < 4; ++j) { v[j] = xr[64 * j]; s += (v[j].x * v[j].x + v[j].y * v[j].y) + (v[j].z * v[j].z + v[j].w * v[j].w); }
        const float rs = 1.0f / sqrtf(wsum(s) * (1.0f / 1024.0f) + EPS);
#pragma unroll
        for (int j = 0; j < 4; ++j) { const f32x4 g = gr[64 * j]; const f32x4 y = v[j] * rs * g;
            o8[64 * j] = (unsigned long long)pk2(y.x, y.y) | ((unsigned long long)pk2(y.z, y.w) << 32); }
    }
    const int gid = vcu * NTHREADS + tid, nth = G * NTHREADS;
    for (int i = gid; i < 4120 * 32; i += nth) {
        const int pi = i >> 5, f = i & 31; const int pos = pi < TPK ? pi : nv::PAST_LEN + (pi - TPK);
        const double inv = pow(10000.0, -(double)f / 32.0), ang = (double)pos * inv;
        p.rope_cos[i] = (float)cos(ang); p.rope_sin[i] = (float)sin(ang);
    }
    for (int i = gid; i < 2048; i += nth) {
        const int g = i >> 6;
        const double dt = exp((double)p.log_dt[g]), ar = p.a_re[i], ai = p.a_im[i];
        const double mag = exp(dt * ar), cr = mag * cos(dt * ai), ci = mag * sin(dt * ai);
        const double nr = cr - 1.0, ni = ci, den = ar * ar + ai * ai;
        const double fr_ = (nr * ar + ni * ai) / den, fi = (ni * ar - nr * ai) / den;
        p.abar_re[i] = (float)cr; p.abar_im[i] = (float)ci;
        for (int j = 0; j < 16; ++j) { const double br = p.b_re[i * 16 + j], bi = p.b_im[i * 16 + j];
            p.bbar_re[i * 16 + j] = (float)(fr_ * br - fi * bi); p.bbar_im[i * 16 + j] = (float)(fr_ * bi + fi * br); }
    }
}

__device__ __forceinline__ void st_bf4(bf16_t* dst, f32x4 v) { u32x2 w; w.x = pk2(v[0], v[1]); w.y = pk2(v[2], v[3]); *(u32x2*)dst = w; }
__device__ __forceinline__ float sq4(f32x4 v) { return (v[0] * v[0] + v[1] * v[1]) + (v[2] * v[2] + v[3] * v[3]); }

struct EpiIn {
    static constexpr bool PERM = false, AFTER_DRAIN = false;
    P p;
    __device__ __forceinline__ void operator()(const f32x4 (&acc)[2][2][4][2], const Unit& u, int wr, int wc, int fr, int fq) const {
        asm volatile("" : "+v"(fr), "+v"(fq));
        const int pm = u.pm, pn = u.pn;
#pragma unroll
        for (int ai = 0; ai < 2; ++ai)
#pragma unroll
            for (int m = 0; m < 4; ++m) {
                const int row = pm * 256 + ai * 128 + wr * 64 + m * 16 + fr;
                if (pn < 2) {
#pragma unroll
                    for (int bj = 0; bj < 2; ++bj)
#pragma unroll
                        for (int n = 0; n < 2; ++n) st_bf4(p.U + (size_t)row * 512 + pn * 256 + bj * 128 + wc * 32 + n * 16 + 4 * fq, acc[ai][bj][m][n]);
                } else if (pn == 2 || pn == 3) {
                    float s = 0.f;
#pragma unroll
                    for (int bj = 0; bj < 2; ++bj)
#pragma unroll
                        for (int n = 0; n < 2; ++n) { const f32x4 v = acc[ai][bj][m][n]; s += sq4(v); const int c = bj * 128 + wc * 32 + n * 16 + 4 * fq;
                            if (pn == 2) { *(f32x4*)(p.CKVF + (size_t)row * 256 + c) = v; st_bf4(p.CKVB + (size_t)row * 256 + c, v); }
                            else st_bf4(p.CQ + (size_t)row * 384 + c, v); }
                    s += __shfl_xor(s, 16); s += __shfl_xor(s, 32);
                    if (fq == 0) { if (pn == 2) p.SSQKV[(size_t)row * 4 + wc] = s; else p.SSQQ[(size_t)row * 8 + wc] = s; }
                } else {
                    if (wc == 0) {
                        const int pi = fr_posidx(row);
#pragma unroll
                        for (int n = 0; n < 2; ++n) { const int i = n * 16 + 4 * fq;
                            const f32x4 c = *(const f32x4*)(p.rope_cos + pi * 32 + i), s = *(const f32x4*)(p.rope_sin + pi * 32 + i);
                            const f32x4 x1 = acc[ai][0][m][n], x2 = acc[ai][1][m][n];
                            const f32x4 y1 = x1 * c - x2 * s, y2 = x1 * s + x2 * c;
                            if (pm < 64) { const int b = row >> 12, tq = row & 4095; float* o = p.out + nv::O_KRP + ((size_t)b * TPK + 16 + tq) * 64 + i; *(f32x4*)o = y1; *(f32x4*)(o + 32) = y2; }
                            else if (pm == 64) { if (row < FR_META + 16) { const int t = row - FR_META;
#pragma unroll
                                    for (int b = 0; b < 4; ++b) { float* o = p.out + nv::O_KRP + ((size_t)b * TPK + t) * 64 + i; *(f32x4*)o = y1; *(f32x4*)(o + 32) = y2; } } }
                            else { float* o = p.out + nv::O_KRS + (size_t)(row - FR_SAMP) * 64 + i; *(f32x4*)o = y1; *(f32x4*)(o + 32) = y2; }
                            if (pm <= 64) {
#pragma unroll
                                for (int h = 0; h < 4; ++h) { bf16_t* kb = p.KB + ((size_t)row * 4 + h) * 192 + 128 + i; st_bf4(kb, y1); st_bf4(kb + 32, y2); } }
                        }
                        if (fq == 0) p.SSQQ[(size_t)row * 8 + 4] = 0.f;
                    } else {
                        float s = 0.f;
#pragma unroll
                        for (int n = 0; n < 2; ++n) { const f32x4 v = acc[ai][0][m][n]; s += sq4(v); st_bf4(p.CQ + (size_t)row * 384 + 256 + 32 * (wc - 1) + n * 16 + 4 * fq, v); }
                        if (wc == 1) {
#pragma unroll
                            for (int n = 0; n < 2; ++n) { const f32x4 v = acc[ai][1][m][n]; s += sq4(v); st_bf4(p.CQ + (size_t)row * 384 + 352 + n * 16 + 4 * fq, v); } }
                        s += __shfl_xor(s, 16); s += __shfl_xor(s, 32);
                        if (fq == 0) p.SSQQ[(size_t)row * 8 + 4 + wc] = s;
                    }
                }
                asm volatile("" ::: "memory");
            }
    }
};
__device__ __forceinline__ float rstd_q(const P& p, int row) { const f32x4 a = *(const f32x4*)(p.SSQQ + (size_t)row * 8), b = *(const f32x4*)(p.SSQQ + (size_t)row * 8 + 4);
    return 1.0f / sqrtf(((a[0] + a[1]) + (a[2] + a[3]) + (b[0] + b[1]) + (b[2] + b[3])) * (1.0f / 384.0f) + EPS); }
__device__ __forceinline__ float rstd_kv(const P& p, int row) { const f32x4 a = *(const f32x4*)(p.SSQKV + (size_t)row * 4);
    return 1.0f / sqrtf(((a[0] + a[1]) + (a[2] + a[3])) * (1.0f / 256.0f) + EPS); }

struct EpiQ {
    static constexpr bool PERM = false, AFTER_DRAIN = false;
    P p;
    __device__ __forceinline__ void operator()(const f32x4 (&acc)[2][2][4][2], const Unit& u, int wr, int wc, int fr, int fq) const {
        asm volatile("" : "+v"(fr), "+v"(fq));
        const int pm = u.pm, pn = u.pn;
#pragma unroll
        for (int ai = 0; ai < 2; ++ai)
#pragma unroll
            for (int m = 0; m < 4; ++m) {
                const int row = pm * 256 + ai * 128 + wr * 64 + m * 16 + fr;
                const float rs = rstd_q(p, row) * C2Q;
                if (pn < 2) {
#pragma unroll
                    for (int bj = 0; bj < 2; ++bj)
#pragma unroll
                        for (int n = 0; n < 2; ++n) st_bf4(p.QB + ((size_t)row * 4 + 2 * pn + bj) * 192 + wc * 32 + n * 16 + 4 * fq, acc[ai][bj][m][n] * rs);
                } else {
                    const int pi = fr_posidx(row);
#pragma unroll
                    for (int n = 0; n < 2; ++n) { const int i = n * 16 + 4 * fq;
                        const f32x4 c = *(const f32x4*)(p.rope_cos + pi * 32 + i), s = *(const f32x4*)(p.rope_sin + pi * 32 + i);
                        const f32x4 x1 = acc[ai][0][m][n] * rs, x2 = acc[ai][1][m][n] * rs;
                        bf16_t* q = p.QB + ((size_t)row * 4 + wc) * 192 + 128 + i; st_bf4(q, x1 * c - x2 * s); st_bf4(q + 32, x1 * s + x2 * c);
                        asm volatile("" ::: "memory"); }
                }
                asm volatile("" ::: "memory");
            }
    }
};
struct EpiKV {
    static constexpr bool PERM = false, AFTER_DRAIN = false;
    P p;
    __device__ __forceinline__ void operator()(const f32x4 (&acc)[2][2][4][2], const Unit& u, int wr, int wc, int fr, int fq) const {
        asm volatile("" : "+v"(fr), "+v"(fq));
        const int pm = u.pm, pn = u.pn;
#pragma unroll
        for (int ai = 0; ai < 2; ++ai)
#pragma unroll
            for (int m = 0; m < 4; ++m) {
                const int row = pm * 256 + ai * 128 + wr * 64 + m * 16 + fr;
                const float rs = rstd_kv(p, row);
#pragma unroll
                for (int bj = 0; bj < 2; ++bj)
#pragma unroll
                    for (int n = 0; n < 2; ++n) { const int j = wc * 32 + n * 16 + 4 * fq; const f32x4 v = acc[ai][bj][m][n] * rs;
                        if (pn < 2) st_bf4(p.KB + ((size_t)row * 4 + 2 * pn + bj) * 192 + j, v);
                        else st_bf4(p.VB + ((size_t)row * 4 + 2 * (pn - 2) + bj) * 128 + j, v); }
                asm volatile("" ::: "memory");
            }
    }
};
__device__ __forceinline__ void ckv_fixup(const P& p, int vcu, int G) {
    const int tid = threadIdx.x, lane = tid & 63, wave = tid >> 6; const int gw = vcu * NWAVES + wave, NGW = G * NWAVES;
    const f32x4 g = *(const f32x4*)(p.g_kv + 4 * lane);
    for (int fr = gw; fr < MP; fr += NGW) {
        if (fr >= FR_META + 16 && fr < FR_SAMP) continue;
        const float rs = rstd_kv(p, fr); const f32x4 v = *(const f32x4*)(p.CKVF + (size_t)fr * 256 + 4 * lane) * rs * g;
        if (fr < FR_META) { const int b = fr >> 12, tq = fr & 4095; *(f32x4*)(p.out + nv::O_CKVP + ((size_t)b * TPK + 16 + tq) * 256 + 4 * lane) = v; }
        else if (fr < FR_SAMP) { const int t = fr - FR_META;
#pragma unroll
            for (int b = 0; b < 4; ++b) *(f32x4*)(p.out + nv::O_CKVP + ((size_t)b * TPK + t) * 256 + 4 * lane) = v; }
        else *(f32x4*)(p.out + nv::O_CKVS + (size_t)(fr - FR_SAMP) * 256 + 4 * lane) = v;
    }
}
}
namespace fk {
__device__ __forceinline__ const float* x0_row(const P& p, int fr) {
    if (fr < FR_META) return p.x_prompt + (size_t)fr * 1024;
    if (fr < FR_SAMP) return p.meta + (size_t)((fr - FR_META) & 15) * 1024;
    return p.x_sample + (size_t)(fr - FR_SAMP) * 1024;
}
struct EpiGLU {
    static constexpr bool PERM = false, AFTER_DRAIN = false;
    P p;
    __device__ __forceinline__ void operator()(const f32x4 (&acc)[2][2][4][2], const Unit& u, int wr, int wc, int fr, int fq) const {
        asm volatile("" : "+v"(fr), "+v"(fq));
#pragma unroll
        for (int ai = 0; ai < 2; ++ai)
#pragma unroll
            for (int m = 0; m < 4; ++m) {
                const int row = u.pm * 256 + ai * 128 + wr * 64 + m * 16 + fr;
#pragma unroll
                for (int bj = 0; bj < 2; ++bj)
#pragma unroll
                    for (int n = 0; n < 2; ++n) { const int c = u.pn * 256 + bj * 128 + wc * 32 + n * 16 + 4 * fq;
                        const u32x2 yb = *(const u32x2*)(p.YS + (size_t)row * 512 + c); const f32x4 a = acc[ai][bj][m][n];
                        f32x4 y; y[0] = __uint_as_float(yb.x << 16); y[1] = __uint_as_float(yb.x & 0xffff0000u); y[2] = __uint_as_float(yb.y << 16); y[3] = __uint_as_float(yb.y & 0xffff0000u);
                        f32x4 o;
#pragma unroll
                        for (int e = 0; e < 4; ++e) o[e] = y[e] * __builtin_amdgcn_rcpf(1.0f + __builtin_amdgcn_exp2f(-1.4426950408889634f * a[e]));
                        st_bf4(p.CAT + (size_t)row * 1024 + c, o); }
                asm volatile("" ::: "memory");
            }
    }
};
struct EpiOut {
    static constexpr bool PERM = false, AFTER_DRAIN = false;
    P p;
    __device__ __forceinline__ void operator()(const f32x4 (&acc)[2][2][4][2], const Unit& u, int wr, int wc, int fr, int fq) const {
        asm volatile("" : "+v"(fr), "+v"(fq));
#pragma unroll
        for (int ai = 0; ai < 2; ++ai)
#pragma unroll
            for (int m = 0; m < 4; ++m) {
                const int row = u.pm * 256 + ai * 128 + wr * 64 + m * 16 + fr; const float* xr = x0_row(p, row); float s = 0.f;
#pragma unroll
                for (int bj = 0; bj < 2; ++bj)
#pragma unroll
                    for (int n = 0; n < 2; ++n) { const int c = u.pn * 256 + bj * 128 + wc * 32 + n * 16 + 4 * fq;
                        const f32x4 v = *(const f32x4*)(xr + c) + acc[ai][bj][m][n]; s += sq4(v);
                        *(f32x4*)(p.X1 + (size_t)row * 1024 + c) = v; st_bf4(p.X1B + (size_t)row * 1024 + c, v); }
                s += __shfl_xor(s, 16); s += __shfl_xor(s, 32);
                if (fq == 0) p.SSQ1[(size_t)row * 16 + u.pn * 4 + wc] = s;
                asm volatile("" ::: "memory");
            }
    }
};
__device__ __forceinline__ float rstd_1(const P& p, int row) { const f32x4* q = (const f32x4*)(p.SSQ1 + (size_t)row * 16); const f32x4 a = q[0] + q[1] + q[2] + q[3];
    return 1.0f / sqrtf(((a[0] + a[1]) + (a[2] + a[3])) * (1.0f / 1024.0f) + EPS); }
struct EpiGU1 {
    static constexpr bool PERM = false, AFTER_DRAIN = false;
    P p;
    __device__ __forceinline__ void operator()(const f32x4 (&acc)[2][2][4][2], const Unit& u, int wr, int wc, int fr, int fq) const {
        asm volatile("" : "+v"(fr), "+v"(fq));
#pragma unroll
        for (int ai = 0; ai < 2; ++ai)
#pragma unroll
            for (int m = 0; m < 4; ++m) {
                const int row = u.pm * 256 + ai * 128 + wr * 64 + m * 16 + fr; const float rs = rstd_1(p, row);
#pragma unroll
                for (int n = 0; n < 2; ++n) { const int f = u.pn * 128 + wc * 32 + n * 16 + 4 * fq;
                    *(f32x4*)(p.GATE + (size_t)row * 2816 + f) = acc[ai][0][m][n] * rs; st_bf4(p.UPB + (size_t)row * 2816 + f, acc[ai][1][m][n] * rs); }
                asm volatile("" ::: "memory");
            }
    }
};
__device__ __forceinline__ void conv_pass(const P& p, int vcu, int G) {
    const int gid = vcu * NTHREADS + threadIdx.x, nth = G * NTHREADS;
    for (int i = gid; i < MP * 704; i += nth) { const int fr = i / 704, f = (i % 704) * 4;
        if (fr >= FR_META + 16 && fr < FR_SAMP) { *(u32x2*)(p.H + (size_t)fr * 2816 + f) = (u32x2){0u, 0u}; continue; }
        const f32x4 g2 = *(const f32x4*)(p.GATE + (size_t)fr * 2816 + f); f32x4 g1, g0; const f32x4 z = {0.f, 0.f, 0.f, 0.f};
        if (fr < FR_META) { const int tq = fr & 4095;
            g1 = *(const f32x4*)(p.GATE + (size_t)(tq >= 1 ? fr - 1 : FR_META + 15) * 2816 + f);
            g0 = *(const f32x4*)(p.GATE + (size_t)(tq >= 2 ? fr - 2 : FR_META + 14 + tq) * 2816 + f); }
        else if (fr < FR_SAMP) { const int t = fr - FR_META;
            g1 = t >= 1 ? *(const f32x4*)(p.GATE + (size_t)(fr - 1) * 2816 + f) : z; g0 = t >= 2 ? *(const f32x4*)(p.GATE + (size_t)(fr - 2) * 2816 + f) : z; }
        else { const int s = fr - FR_SAMP, db = s >> 3, ts = s & 7;
            g1 = ts >= 1 ? *(const f32x4*)(p.GATE + (size_t)(fr - 1) * 2816 + f) : *(const f32x4*)(p.st_conv + ((size_t)db * 2 + 1) * 2816 + f);
            g0 = ts >= 2 ? *(const f32x4*)(p.GATE + (size_t)(fr - 2) * 2816 + f) : *(const f32x4*)(p.st_conv + ((size_t)db * 2 + ts) * 2816 + f); }
        const f32x4 w0 = *(const f32x4*)(p.conv_w + f), w1 = *(const f32x4*)(p.conv_w + 2816 + f), w2 = *(const f32x4*)(p.conv_w + 5632 + f), cb = *(const f32x4*)(p.conv_b + f);
        const u32x2 ub = *(const u32x2*)(p.UPB + (size_t)fr * 2816 + f);
        f32x4 up; up[0] = __uint_as_float(ub.x << 16); up[1] = __uint_as_float(ub.x & 0xffff0000u); up[2] = __uint_as_float(ub.y << 16); up[3] = __uint_as_float(ub.y & 0xffff0000u);
        const f32x4 c = cb + w0 * g0 + w1 * g1 + w2 * g2; f32x4 h;
#pragma unroll
        for (int e = 0; e < 4; ++e) h[e] = c[e] * __builtin_amdgcn_rcpf(1.0f + __builtin_amdgcn_exp2f(-1.4426950408889634f * c[e])) * up[e];
        st_bf4(p.H + (size_t)fr * 2816 + f, h);
        if (fr < FR_META) { const int b = fr >> 12, tq = fr & 4095; if (tq >= 4094) *(f32x4*)(p.out + nv::O_CONVP + ((size_t)b * 2 + (tq - 4094)) * 2816 + f) = g2; }
        else if (fr >= FR_SAMP) { const int s = fr - FR_SAMP, db = s >> 3, ts = s & 7; if (ts >= 6) *(f32x4*)(p.out + nv::O_CONVS + ((size_t)db * 2 + (ts - 6)) * 2816 + f) = g2; }
    }
}
struct EpiDown1 {
    static constexpr bool PERM = false, AFTER_DRAIN = false;
    P p;
    __device__ __forceinline__ void operator()(const f32x4 (&acc)[2][2][4][2], const Unit& u, int wr, int wc, int fr, int fq) const {
        asm volatile("" : "+v"(fr), "+v"(fq));
#pragma unroll
        for (int ai = 0; ai < 2; ++ai)
#pragma unroll
            for (int m = 0; m < 4; ++m) {
                const int row = u.pm * 256 + ai * 128 + wr * 64 + m * 16 + fr;
#pragma unroll
                for (int bj = 0; bj < 2; ++bj)
#pragma unroll
                    for (int n = 0; n < 2; ++n) { const size_t o = (size_t)row * 1024 + u.pn * 256 + bj * 128 + wc * 32 + n * 16 + 4 * fq;
                        *(f32x4*)(p.X2 + o) = *(const f32x4*)(p.X1 + o) + acc[ai][bj][m][n]; }
                asm volatile("" ::: "memory");
            }
    }
};
__device__ __forceinline__ void final_pass(const P& p, int vcu, int G) {
    const int lane = threadIdx.x & 63, wave = threadIdx.x >> 6; const int gw = vcu * NWAVES + wave, NGW = G * NWAVES;
    for (int fr = gw; fr < MP; fr += NGW) {
        float* dst;
        if (fr < FR_META) dst = p.out + nv::O_YP + (size_t)fr * 1024; else if (fr >= FR_SAMP) dst = p.out + nv::O_YS + (size_t)(fr - FR_SAMP) * 1024; else continue;
        const f32x4* xr = (const f32x4*)(p.X2 + (size_t)fr * 1024) + lane; const f32x4* gr = (const f32x4*)p.g_final + lane;
        f32x4 v[4]; float s = 0.f;
#pragma unroll
        for (int j = 0; j < 4; ++j) { v[j] = xr[64 * j]; s += sq4(v[j]); }
        const float rs = 1.0f / sqrtf(wsum(s) * (1.0f / 1024.0f) + EPS);
#pragma unroll
        for (int j = 0; j < 4; ++j) ((f32x4*)dst + lane)[64 * j] = v[j] * rs * gr[64 * j];
    }
}
}
namespace fk {
typedef short s16x4 __attribute__((ext_vector_type(4)));
typedef float f32x16 __attribute__((ext_vector_type(16)));
#define FK_SBAR() __builtin_amdgcn_sched_barrier(0)
constexpr int AT_KROW = 400;
constexpr int AT_KHALF = 64 * AT_KROW;
constexpr int AT_VOFF = 2 * AT_KHALF;
constexpr int AT_VHALF = 64 * 128 * 2;
constexpr int AT_WS = AT_VOFF + 2 * AT_VHALF;
constexpr int AT_LDS = AT_WS + 8 * 64 * 4;
__device__ __forceinline__ int v_st(int k, int c) { const int kk = (k & ~0xC) | ((k & 4) << 1) | ((k & 8) >> 1); return ((kk >> 3) * 4 + (c >> 5)) * 512 + ((kk & 7) * 32 + (c & 31)) * 2; }
__device__ __forceinline__ int v_rd_base(int lane) { return ((lane & 3) << 3) | (((lane >> 2) & 3) << 6) | (((lane >> 4) & 1) << 5) | (((lane >> 5) & 1) << 8); }
constexpr int v_rd_off(int d0, int ks, int half) { return d0 * 512 + ks * 4096 + half * 2048; }
__device__ __forceinline__ int crow(int r, int hi) { return (r & 3) + 8 * (r >> 2) + 4 * hi; }
__device__ __forceinline__ unsigned cvtpk(float lo, float hi) { unsigned r; asm volatile("v_cvt_pk_bf16_f32 %0, %1, %2" : "=v"(r) : "v"(lo), "v"(hi)); return r; }
__device__ __forceinline__ void mask_tile(f32x16& p0, f32x16& p1, int dq, unsigned W) {
    const float NEG = -__builtin_inff();
#pragma unroll
    for (int r = 0; r < 16; ++r) { const int c = (r & 3) + 8 * (r >> 2);
        if ((unsigned)(dq - c) >= W) p0[r] = NEG;
        if ((unsigned)(dq - c - 32) >= W) p1[r] = NEG; }
}
constexpr float AT_THR = 8.f;
__device__ __forceinline__ void partialSM(f32x16& p0, f32x16& p1, float& m_reg, float& alpha) {
    float pmax = p0[0];
#pragma unroll
    for (int r = 1; r < 16; ++r) pmax = fmaxf(pmax, p0[r]);
#pragma unroll
    for (int r = 0; r < 16; ++r) pmax = fmaxf(pmax, p1[r]);
    { auto rr = __builtin_amdgcn_permlane32_swap(__float_as_uint(pmax), __float_as_uint(pmax), false, false);
      pmax = fmaxf(__uint_as_float(rr[0]), __uint_as_float(rr[1])); }
    float mn;
    if (__builtin_expect(__all((pmax - m_reg) <= AT_THR), 1)) { mn = m_reg; alpha = 1.f; }
    else { mn = fmaxf(m_reg, pmax); alpha = __builtin_amdgcn_exp2f(m_reg - mn); m_reg = mn; }
#pragma unroll
    for (int r = 0; r < 16; ++r) { p0[r] = __builtin_amdgcn_exp2f(p0[r] - mn); p1[r] = p1[r] - mn; }
}
__device__ __forceinline__ void finishSM(f32x16& p0, f32x16& p1, float alpha, float& l_reg, bf16x8& pa0, bf16x8& pa1, bf16x8& pa2, bf16x8& pa3) {
#pragma unroll
    for (int r = 0; r < 16; ++r) p1[r] = __builtin_amdgcn_exp2f(p1[r]);
    float ps = 0;
#pragma unroll
    for (int r = 0; r < 16; ++r) ps += p0[r];
#pragma unroll
    for (int r = 0; r < 16; ++r) ps += p1[r];
    { auto rr = __builtin_amdgcn_permlane32_swap(__float_as_uint(ps), __float_as_uint(ps), false, false);
      ps = __uint_as_float(rr[0]) + __uint_as_float(rr[1]); }
    l_reg = l_reg * alpha + ps;
#define FK_PK4(P, B_, OUT) do { unsigned a0 = cvtpk(P[B_+0], P[B_+1]), a1 = cvtpk(P[B_+2], P[B_+3]);                          \
        unsigned b0 = cvtpk(P[B_+4], P[B_+5]), b1 = cvtpk(P[B_+6], P[B_+7]);                                             \
        auto r0 = __builtin_amdgcn_permlane32_swap(a0, b0, false, false); auto r1 = __builtin_amdgcn_permlane32_swap(a1, b1, false, false); \
        v4u w = {r0[0], r1[0], r0[1], r1[1]}; OUT = *reinterpret_cast<bf16x8*>(&w); } while (0)
    FK_PK4(p0, 0, pa0); FK_PK4(p0, 8, pa1); FK_PK4(p1, 0, pa2); FK_PK4(p1, 8, pa3);
#undef FK_PK4
}
__device__ __forceinline__ void pv_tile(f32x16* o, int vb0, bf16x8 pa0, bf16x8 pa1, bf16x8 pa2, bf16x8 pa3) {
#define FK_TRRD(dst, off) asm volatile("ds_read_b64_tr_b16 %0, %1 offset:%2" : "=&v"(dst) : "v"(vb0), "i"(off) : "memory")
#define FK_PV_D0(d0) do { s16x4 l0, l1, l2, l3, h0, h1, h2, h3; constexpr int b_ = v_rd_off(d0, 0, 0); \
        FK_TRRD(l0, b_); FK_TRRD(h0, b_ + 2048); FK_TRRD(l1, b_ + 4096); FK_TRRD(h1, b_ + 6144); FK_TRRD(l2, b_ + 8192); FK_TRRD(h2, b_ + 10240); FK_TRRD(l3, b_ + 12288); FK_TRRD(h3, b_ + 14336); \
        asm volatile("s_waitcnt lgkmcnt(0)" ::: "memory"); FK_SBAR(); \
        o[d0] = __builtin_amdgcn_mfma_f32_32x32x16_bf16(pa0, (bf16x8){l0[0], l0[1], l0[2], l0[3], h0[0], h0[1], h0[2], h0[3]}, o[d0], 0, 0, 0);   \
        o[d0] = __builtin_amdgcn_mfma_f32_32x32x16_bf16(pa1, (bf16x8){l1[0], l1[1], l1[2], l1[3], h1[0], h1[1], h1[2], h1[3]}, o[d0], 0, 0, 0);   \
        o[d0] = __builtin_amdgcn_mfma_f32_32x32x16_bf16(pa2, (bf16x8){l2[0], l2[1], l2[2], l2[3], h2[0], h2[1], h2[2], h2[3]}, o[d0], 0, 0, 0);   \
        o[d0] = __builtin_amdgcn_mfma_f32_32x32x16_bf16(pa3, (bf16x8){l3[0], l3[1], l3[2], l3[3], h3[0], h3[1], h3[2], h3[3]}, o[d0], 0, 0, 0); } while (0)
    FK_PV_D0(0); FK_PV_D0(1); FK_PV_D0(2); FK_PV_D0(3);
#undef FK_PV_D0
#undef FK_TRRD
}
__device__ __forceinline__ int kpos_row(int b, int kp) { return kp < 16 ? FR_META + kp : (kp < TPK ? b * 4096 + kp - 16 : b * 4096 + 4095); }

__device__ __forceinline__ void attn_prompt_unit(const P& p, LAS unsigned char* lds, int b, int h, int j2) {
    const int tid = threadIdx.x, lane = tid & 63, wid = __builtin_amdgcn_readfirstlane(tid >> 6), r32 = lane & 31, hi = lane >> 5;
    const int wq = wid & 3, kh = wid >> 2;
    const int tq0 = 128 * j2 + 32 * wq, pq0 = 16 + tq0;
    LAS unsigned char* K_lds = lds; LAS unsigned char* V_lds = lds + AT_VOFF;
    LAS float* wsf = (LAS float*)(lds + AT_WS) + wid * 64; LAS float* li_l = wsf; LAS float* al_l = wsf + 32;
    bf16x8 qr[12];
    { const bf16_t* qp = p.QB + ((size_t)(b * 4096 + tq0 + r32) * 4 + h) * 192 + hi * 8;
#pragma unroll
      for (int d0 = 0; d0 < 12; ++d0) qr[d0] = *(const bf16x8*)(qp + d0 * 16); }
    float m_reg = -1e30f, l_reg = 0.f; f32x16 o[4] = {};
    const int NDT = j2 + 2;
    v4u sk[6], sv[4];
#define FK_STAGE_LOAD(dt) do { const int kp0_ = 128 * (dt); int tl_ = tid; asm volatile("" : "+v"(tl_));   \
        _Pragma("unroll") for (int i_ = 0; i_ < 6; ++i_) { const int ci = tl_ + 512 * i_, key = ci / 24, ch = ci - key * 24; \
            sk[i_] = *(const v4u*)(p.KB + ((size_t)kpos_row(b, kp0_ + key) * 4 + h) * 192 + ch * 8); } \
        _Pragma("unroll") for (int i_ = 0; i_ < 4; ++i_) { const int ci = tl_ + 512 * i_, key = ci >> 4, ch = ci & 15; \
            sv[i_] = *(const v4u*)(p.VB + ((size_t)kpos_row(b, kp0_ + key) * 4 + h) * 128 + ch * 8); } } while (0)
#define FK_STAGE_WRITE() do { int tl_ = tid; asm volatile("" : "+v"(tl_)); \
        _Pragma("unroll") for (int i_ = 0; i_ < 6; ++i_) { const int ci = tl_ + 512 * i_, key = ci / 24, ch = ci - key * 24; \
            *(LAS v4u*)(K_lds + (key >> 6) * AT_KHALF + (key & 63) * AT_KROW + ch * 16) = sk[i_]; } \
        _Pragma("unroll") for (int i_ = 0; i_ < 4; ++i_) { const int ci = tl_ + 512 * i_, key = ci >> 4, ch = ci & 15; \
            *(LAS v4u*)(V_lds + (key >> 6) * AT_VHALF + v_st(key & 63, ch * 8)) = sv[i_]; } } while (0)
    FK_STAGE_LOAD(0);
    const int vb0 = (int)(unsigned)(size_t)(V_lds + kh * AT_VHALF) + v_rd_base(lane);
    const LAS unsigned char* kbp = K_lds + kh * AT_KHALF + r32 * AT_KROW + hi * 16;
    for (int dt = 0; dt < NDT; ++dt) {
        __syncthreads();
        FK_STAGE_WRITE();
        if (dt + 1 < NDT) FK_STAGE_LOAD(dt + 1);
        __syncthreads();
        const int kb = 128 * dt + 64 * kh;
        f32x16 p0 = {}, p1 = {};
#pragma unroll
        for (int d0 = 0; d0 < 12; ++d0) {
            const bf16x8 b0 = *(const LAS bf16x8*)(kbp + 32 * d0), b1 = *(const LAS bf16x8*)(kbp + 32 * AT_KROW + 32 * d0);
            p0 = __builtin_amdgcn_mfma_f32_32x32x16_bf16(b0, qr[d0], p0, 0, 0, 0);
            p1 = __builtin_amdgcn_mfma_f32_32x32x16_bf16(b1, qr[d0], p1, 0, 0, 0); }
        if (kb + 63 > pq0) mask_tile(p0, p1, pq0 + r32 - kb - 4 * hi, 0x7fffffffu);
        float alpha; bf16x8 pa0, pa1, pa2, pa3;
        partialSM(p0, p1, m_reg, alpha);
        finishSM(p0, p1, alpha, l_reg, pa0, pa1, pa2, pa3);
        if (__any(alpha < 1.f)) { if (hi == 0) al_l[r32] = alpha; asm volatile("s_waitcnt lgkmcnt(0)" ::: "memory");
#pragma unroll
            for (int d_ = 0; d_ < 4; ++d_)
#pragma unroll
                for (int r = 0; r < 16; ++r) o[d_][r] *= al_l[crow(r, hi)]; }
        FK_SBAR();
        pv_tile(o, vb0, pa0, pa1, pa2, pa3);
    }
#undef FK_STAGE_LOAD
#undef FK_STAGE_WRITE
    __syncthreads();
    LAS float* mb = (LAS float*)lds;
    LAS float* ob = (LAS float*)(lds + 1024);
    if (kh == 1) { if (hi == 0) { mb[wq * 64 + r32] = m_reg; mb[wq * 64 + 32 + r32] = l_reg; }
#pragma unroll
        for (int d_ = 0; d_ < 4; ++d_)
#pragma unroll
            for (int r = 0; r < 16; ++r) ob[(wq * 64 + d_ * 16 + r) * 64 + lane] = o[d_][r]; }
    __syncthreads();
    if (kh == 0) {
        const float m2 = mb[wq * 64 + r32], l2 = mb[wq * 64 + 32 + r32];
        const float M = fmaxf(m_reg, m2), f1 = __builtin_amdgcn_exp2f(m_reg - M), f2 = __builtin_amdgcn_exp2f(m2 - M);
        const float l = l_reg * f1 + l2 * f2, rl = __builtin_amdgcn_rcpf(l);
        if (hi == 0) { li_l[r32] = f1 * rl; al_l[r32] = f2 * rl; }
        asm volatile("s_waitcnt lgkmcnt(0)" ::: "memory");
        bf16_t* Ow = p.CAT + (size_t)(b * 4096 + tq0) * 1024 + 512 + h * 128;
#pragma unroll
        for (int r = 0; r < 16; ++r) { const int orow = crow(r, hi); const float g1 = li_l[orow], g2 = al_l[orow];
#pragma unroll
            for (int d0 = 0; d0 < 4; ++d0) { const float v = o[d0][r] * g1 + ob[(wq * 64 + d0 * 16 + r) * 64 + lane] * g2;
                const float vn = __shfl_xor(v, 1);
                if ((r32 & 1) == 0) *(unsigned*)(Ow + (size_t)orow * 1024 + d0 * 32 + r32) = cvtpk(v, vn); } }
    }
    __syncthreads();
}
__device__ __forceinline__ void attn_meta(const P& p, LAS unsigned char* lds) {
    const int tid = threadIdx.x; LAS float* sc = (LAS float*)lds;
#pragma unroll 1
    for (int idx = tid; idx < 1024; idx += NTHREADS) { const int t = idx >> 6, h = (idx >> 4) & 3, k = idx & 15; float s = -__builtin_inff();
        if (k <= t) { s = 0.f; const bf16_t* q = p.QB + ((size_t)(FR_META + t) * 4 + h) * 192; const bf16_t* kk = p.KB + ((size_t)(FR_META + k) * 4 + h) * 192;
            for (int d = 0; d < 192; ++d) s += bf2f(q[d]) * bf2f(kk[d]); }
        sc[idx] = s; }
    __syncthreads();
#pragma unroll 1
    for (int it = tid; it < 2048; it += NTHREADS) { const int t = it >> 7, h = (it >> 5) & 3, v = (it & 31) * 4; const LAS float* s = sc + (t * 4 + h) * 16;
        float mx = s[0]; for (int k = 1; k <= t; ++k) mx = fmaxf(mx, s[k]);
        float l = 0.f; f32x4 acc = {0.f, 0.f, 0.f, 0.f};
        for (int k = 0; k <= t; ++k) { const float pk = __builtin_amdgcn_exp2f(s[k] - mx); l += pk; const bf16_t* vv = p.VB + ((size_t)(FR_META + k) * 4 + h) * 128 + v;
            acc[0] += pk * bf2f(vv[0]); acc[1] += pk * bf2f(vv[1]); acc[2] += pk * bf2f(vv[2]); acc[3] += pk * bf2f(vv[3]); }
        st_bf4(p.CAT + (size_t)(FR_META + t) * 1024 + 512 + h * 128 + v, acc * (1.0f / l)); }
    __syncthreads();
}
__device__ __forceinline__ void attn_prompt_phase(const P& p, LAS unsigned char* lds, int vcu, int G) {
    if (vcu == 0) attn_meta(p, lds);
    for (int item = vcu; item < 256; item += G) { const int bh = item >> 4, s = item & 15;
        attn_prompt_unit(p, lds, bh >> 2, bh & 3, 31 - s);
        attn_prompt_unit(p, lds, bh >> 2, bh & 3, s); }
}
}
namespace fk {
constexpr int SA_PITCH = 656;
constexpr int SA_Q = 0, SA_K = 32 * SA_PITCH, SA_V = SA_K + 64 * SA_PITCH, SA_WS = SA_V + 32768, SA_LDS = SA_WS + 2048;
constexpr int AP_STRIDE = 32 * 256 + 64;
__device__ __forceinline__ bf16x8 pack8f(f32x4 a, f32x4 b) { v4u w = {pk2(a[0], a[1]), pk2(a[2], a[3]), pk2(b[0], b[1]), pk2(b[2], b[3])}; return *reinterpret_cast<bf16x8*>(&w); }

__device__ __forceinline__ void attn_sample_unit(const P& p, LAS unsigned char* lds, int db, int half, int item) {
    const int tid = threadIdx.x, lane = tid & 63, wid = __builtin_amdgcn_readfirstlane(tid >> 6), r32 = lane & 31, hi = lane >> 5;
    const int quad = wid >> 2, cg = wid & 3;
    LAS unsigned char* Qs = lds + SA_Q; LAS unsigned char* Ks = lds + SA_K; LAS unsigned char* Vs = lds + SA_V;
    LAS float* wsf = (LAS float*)(lds + SA_WS) + wid * 64; LAS float* al_l = wsf + 32;
    { LAS float* qn = (LAS float*)Ks;
      for (int e = tid; e < 32 * 128; e += NTHREADS) { const int m = e >> 7, n = e & 127; qn[e] = bf2f(p.QB[((size_t)(FR_SAMP + db * 8 + (m >> 2)) * 4 + (m & 3)) * 192 + n]); }
      for (int e = tid; e < 32 * 64; e += NTHREADS) { const int m = e >> 6, i = e & 63;
          *(LAS bf16_t*)(Qs + m * SA_PITCH + (256 + i) * 2) = p.QB[((size_t)(FR_SAMP + db * 8 + (m >> 2)) * 4 + (m & 3)) * 192 + 128 + i]; }
      __syncthreads();
      const int r = tid & 255, hp = tid >> 8;
#pragma unroll 1
      for (int hh = 0; hh < 2; ++hh) { const int h = 2 * hp + hh; const f32x4* wr = (const f32x4*)(p.w_uk + (size_t)r * 512 + h * 128);
          float a[8];
#pragma unroll
          for (int qi = 0; qi < 8; ++qi) a[qi] = 0.f;
#pragma unroll 4
          for (int n4 = 0; n4 < 32; ++n4) { const f32x4 w = wr[n4];
#pragma unroll
              for (int qi = 0; qi < 8; ++qi) { const f32x4 q = *(const LAS f32x4*)(qn + (qi * 4 + h) * 128 + n4 * 4); a[qi] += (q[0] * w[0] + q[1] * w[1]) + (q[2] * w[2] + q[3] * w[3]); } }
#pragma unroll
          for (int qi = 0; qi < 8; ++qi) *(LAS bf16_t*)(Qs + (qi * 4 + h) * SA_PITCH + r * 2) = (bf16_t)(pk2(a[qi], a[qi]) & 0xffffu); }
      __syncthreads(); }
    const int NT = half ? 65 : 64;
    float m_reg = -1e30f, l_reg = 0.f; f32x16 o[2] = {};
    f32x4 sg[10];
#define FK_SLOAD(t) do { int tl_ = tid; asm volatile("" : "+v"(tl_)); const int key = tl_ >> 3, c8 = tl_ & 7; const float* cr; const float* kr; \
        if ((t) < 64) { const int j0 = half * 4096 + (t) * 64; const int pg = __builtin_amdgcn_readfirstlane(p.page_table[db * 64 + (j0 >> 7)]); const size_t rr = (size_t)pg * 128 + (j0 & 127) + key; \
            cr = p.cache_ckv + rr * 256; kr = p.cache_kr + rr * 64; } \
        else { const size_t rr = (size_t)db * 8 + (key & 7); cr = p.out + nv::O_CKVS + rr * 256; kr = p.out + nv::O_KRS + rr * 64; } \
        _Pragma("unroll") for (int i_ = 0; i_ < 4; ++i_) { sg[2 * i_] = *(const f32x4*)(cr + 8 * c8 + 64 * i_); sg[2 * i_ + 1] = *(const f32x4*)(cr + 8 * c8 + 64 * i_ + 4); } \
        sg[8] = *(const f32x4*)(kr + 8 * c8); sg[9] = *(const f32x4*)(kr + 8 * c8 + 4); } while (0)
#define FK_SWRITE() do { int tl_ = tid; asm volatile("" : "+v"(tl_)); const int key = tl_ >> 3, c8 = tl_ & 7; \
        _Pragma("unroll") for (int i_ = 0; i_ < 4; ++i_) { const bf16x8 v = pack8f(sg[2 * i_], sg[2 * i_ + 1]); const int col = 8 * c8 + 64 * i_; \
            *(LAS bf16x8*)(Ks + key * SA_PITCH + col * 2) = v; *(LAS bf16x8*)(Vs + (col >> 7) * 16384 + v_st(key, col & 127)) = v; } \
        *(LAS bf16x8*)(Ks + key * SA_PITCH + (256 + 8 * c8) * 2) = pack8f(sg[8], sg[9]); } while (0)
    FK_SLOAD(0);
    const LAS unsigned char* kbp = Ks + (32 * quad + r32) * SA_PITCH + hi * 16;
    const LAS unsigned char* qbp = Qs + r32 * SA_PITCH + hi * 16;
    const int vb0 = (int)(unsigned)(size_t)(Vs + (cg >> 1) * 16384) + v_rd_base(lane) + (2 * (cg & 1)) * 512 + (2 * quad) * 4096;
    for (int t = 0; t < NT; ++t) {
        __syncthreads();
        FK_SWRITE();
        if (t + 1 < NT) FK_SLOAD(t + 1);
        __syncthreads();
        f32x16 p0 = {};
#pragma unroll
        for (int d0 = 0; d0 < 20; ++d0) { const bf16x8 kf = *(const LAS bf16x8*)(kbp + 32 * d0), qf = *(const LAS bf16x8*)(qbp + 32 * d0);
            p0 = __builtin_amdgcn_mfma_f32_32x32x16_bf16(kf, qf, p0, 0, 0, 0); }
        if (t == 64) {
            const float NEG = -__builtin_inff();
#pragma unroll
            for (int r = 0; r < 16; ++r) { const int kk = 32 * quad + crow(r, hi); if (!(kk < 8 && kk <= (r32 >> 2))) p0[r] = NEG; } }
        float pmax = p0[0];
#pragma unroll
        for (int r = 1; r < 16; ++r) pmax = fmaxf(pmax, p0[r]);
        { auto rr = __builtin_amdgcn_permlane32_swap(__float_as_uint(pmax), __float_as_uint(pmax), false, false); pmax = fmaxf(__uint_as_float(rr[0]), __uint_as_float(rr[1])); }
        float mn, alpha;
        if (__builtin_expect(__all((pmax - m_reg) <= AT_THR), 1)) { mn = m_reg; alpha = 1.f; }
        else { mn = fmaxf(m_reg, pmax); alpha = __builtin_amdgcn_exp2f(m_reg - mn); m_reg = mn; }
        float ps = 0.f;
#pragma unroll
        for (int r = 0; r < 16; ++r) { p0[r] = __builtin_amdgcn_exp2f(p0[r] - mn); ps += p0[r]; }
        { auto rr = __builtin_amdgcn_permlane32_swap(__float_as_uint(ps), __float_as_uint(ps), false, false); ps = __uint_as_float(rr[0]) + __uint_as_float(rr[1]); }
        l_reg = l_reg * alpha + ps;
        bf16x8 pa0, pa1;
#define FK_PK4(P, B_, OUT) do { unsigned a0 = cvtpk(P[B_+0], P[B_+1]), a1 = cvtpk(P[B_+2], P[B_+3]); unsigned b0 = cvtpk(P[B_+4], P[B_+5]), b1 = cvtpk(P[B_+6], P[B_+7]); \
        auto r0 = __builtin_amdgcn_permlane32_swap(a0, b0, false, false); auto r1 = __builtin_amdgcn_permlane32_swap(a1, b1, false, false); \
        v4u w = {r0[0], r1[0], r0[1], r1[1]}; OUT = *reinterpret_cast<bf16x8*>(&w); } while (0)
        FK_PK4(p0, 0, pa0); FK_PK4(p0, 8, pa1);
#undef FK_PK4
        if (__any(alpha < 1.f)) { if (hi == 0) al_l[r32] = alpha; asm volatile("s_waitcnt lgkmcnt(0)" ::: "memory");
#pragma unroll
            for (int d_ = 0; d_ < 2; ++d_)
#pragma unroll
                for (int r = 0; r < 16; ++r) o[d_][r] *= al_l[crow(r, hi)]; }
        FK_SBAR();
#define FK_TRRD(dst, off) asm volatile("ds_read_b64_tr_b16 %0, %1 offset:%2" : "=&v"(dst) : "v"(vb0), "i"(off) : "memory")
#define FK_PV2(d) do { s16x4 l0, l1, h0, h1; FK_TRRD(l0, (d) * 512); FK_TRRD(h0, (d) * 512 + 2048); FK_TRRD(l1, (d) * 512 + 4096); FK_TRRD(h1, (d) * 512 + 6144); \
        asm volatile("s_waitcnt lgkmcnt(0)" ::: "memory"); FK_SBAR(); \
        o[d] = __builtin_amdgcn_mfma_f32_32x32x16_bf16(pa0, (bf16x8){l0[0], l0[1], l0[2], l0[3], h0[0], h0[1], h0[2], h0[3]}, o[d], 0, 0, 0); \
        o[d] = __builtin_amdgcn_mfma_f32_32x32x16_bf16(pa1, (bf16x8){l1[0], l1[1], l1[2], l1[3], h1[0], h1[1], h1[2], h1[3]}, o[d], 0, 0, 0); } while (0)
        FK_PV2(0); FK_PV2(1);
#undef FK_PV2
#undef FK_TRRD
    }
#undef FK_SLOAD
#undef FK_SWRITE
    __syncthreads();
    LAS float* mb = (LAS float*)(lds + SA_K);
    LAS float* ob = (LAS float*)(lds + SA_K + 1024);
    if (quad == 1) { if (hi == 0) { mb[cg * 64 + r32] = m_reg; mb[cg * 64 + 32 + r32] = l_reg; }
#pragma unroll
        for (int d_ = 0; d_ < 2; ++d_)
#pragma unroll
            for (int r = 0; r < 16; ++r) ob[(cg * 32 + d_ * 16 + r) * 64 + lane] = o[d_][r]; }
    __syncthreads();
    if (quad == 0) {
        const float m2 = mb[cg * 64 + r32], l2 = mb[cg * 64 + 32 + r32];
        const float M = fmaxf(m_reg, m2), f1 = __builtin_amdgcn_exp2f(m_reg - M), f2 = __builtin_amdgcn_exp2f(m2 - M);
        const float l = l_reg * f1 + l2 * f2;
        if (hi == 0) { wsf[r32] = f1; al_l[r32] = f2; }
        asm volatile("s_waitcnt lgkmcnt(0)" ::: "memory");
        float* ap = p.APART + (size_t)item * AP_STRIDE;
        if (cg == 0 && hi == 0) { ap[32 * 256 + r32] = M; ap[32 * 256 + 32 + r32] = l; }
#pragma unroll
        for (int r = 0; r < 16; ++r) { const int orow = crow(r, hi); const float g1 = wsf[orow], g2 = al_l[orow];
#pragma unroll
            for (int d_ = 0; d_ < 2; ++d_) ap[orow * 256 + 64 * cg + 32 * d_ + r32] = o[d_][r] * g1 + ob[(cg * 32 + d_ * 16 + r) * 64 + lane] * g2; }
    }
    __syncthreads();
}
__device__ __forceinline__ void attn_sample_phase(const P& p, LAS unsigned char* lds, int vcu, int G) {
    for (int item = vcu; item < 256; item += G) attn_sample_unit(p, lds, item >> 1, item & 1, item);
}
__device__ __forceinline__ void attn_sample_combine(const P& p, LAS unsigned char* lds, int vcu, int G) {
    const int tid = threadIdx.x; LAS float* ol = (LAS float*)lds;
    for (int db = vcu; db < 128; db += G) {
        const float* a0 = p.APART + (size_t)(2 * db) * AP_STRIDE; const float* a1 = a0 + AP_STRIDE;
        __syncthreads();
        for (int e = tid; e < 32 * 256; e += NTHREADS) { const int m = e >> 8;
            const float m0 = a0[8192 + m], m1 = a1[8192 + m], l0 = a0[8192 + 32 + m], l1 = a1[8192 + 32 + m];
            const float M = fmaxf(m0, m1), f0 = __builtin_amdgcn_exp2f(m0 - M), f1 = __builtin_amdgcn_exp2f(m1 - M);
            ol[e] = (a0[e] * f0 + a1[e] * f1) / (l0 * f0 + l1 * f1); }
        __syncthreads();
        const int h = tid >> 7, v = tid & 127; float acc[8];
#pragma unroll
        for (int qi = 0; qi < 8; ++qi) acc[qi] = 0.f;
#pragma unroll 4
        for (int r = 0; r < 256; ++r) { const float w = p.w_uv[(size_t)r * 512 + h * 128 + v];
#pragma unroll
            for (int qi = 0; qi < 8; ++qi) acc[qi] += ol[(qi * 4 + h) * 256 + r] * w; }
#pragma unroll
        for (int qi = 0; qi < 8; ++qi) p.CAT[(size_t)(FR_SAMP + db * 8 + qi) * 1024 + 512 + h * 128 + v] = (bf16_t)(pk2(acc[qi], acc[qi]) & 0xffffu);
    }
    __syncthreads();
}
}
namespace fk {
constexpr int LDS_BYTES = 147456;
extern __shared__ __attribute__((aligned(16))) unsigned char lds_dyn[];
__device__ __forceinline__ int get_vcu() { const int G = gridDim.x, bx = blockIdx.x; return (G % 8 == 0) ? (bx % 8) * (G / 8) + bx / 8 : bx; }
__global__ void __launch_bounds__(512, 2) k_prologue(P p) { prologue(p, (LAS unsigned char*)lds_dyn, get_vcu(), gridDim.x); }
__global__ void __launch_bounds__(512, 2) k_p1(P p) {
    pg8::Gemm g{p.XN, p.Bt_in, MP, 1280, 1024}; pg8::StaticOrder S; S.init(MP, 1280, gridDim.x, blockIdx.x); EpiIn E{p};
    pg8::gemm_phase<EpiIn, pg8::StaticOrder, true, true>((LAS unsigned char*)lds_dyn, g, S, E);
}
__global__ void __launch_bounds__(512, 2) k_p2a(P p) {
    { pg8::Gemm g{p.CQ, p.Bt_uq, MP, 768, 384}; pg8::StaticOrder S; S.init(MP, 768, gridDim.x, blockIdx.x); EpiQ E{p};
      pg8::gemm_phase<EpiQ, pg8::StaticOrder, true, true>((LAS unsigned char*)lds_dyn, g, S, E); }
}
__global__ void __launch_bounds__(512, 2) k_p2b(P p) {
    { pg8::Gemm g{p.CKVB, p.Bt_kv, 65 * 256, 1024, 256}; pg8::StaticOrder S; S.init(65 * 256, 1024, gridDim.x, blockIdx.x); EpiKV E{p};
      pg8::gemm_phase<EpiKV, pg8::StaticOrder, true, true>((LAS unsigned char*)lds_dyn, g, S, E); }
    ckv_fixup(p, get_vcu(), gridDim.x);
}
__device__ __forceinline__ int nat2fr(int r) { if (r < nv::RP) { const int b = r / nv::TP, t = r % nv::TP; return t < 16 ? FR_META + t : b * 4096 + t - 16; } return FR_SAMP + (r - nv::RP); }
__global__ void k_cv_bf(const bf16_t* src, int lds_, int coff, float* dst, int ldd, int doff, int ncols, float scale) {
    const long gid = (long)blockIdx.x * blockDim.x + threadIdx.x, nth = (long)gridDim.x * blockDim.x;
    for (long i = gid; i < (long)nv::R * ncols; i += nth) { const int r = (int)(i / ncols), c = (int)(i % ncols);
        dst[(size_t)r * ldd + doff + c] = bf2f(src[(size_t)nat2fr(r) * lds_ + coff + c]) * scale; }
}
__global__ void k_cv_qb(const bf16_t* QB, float* q, float* q_rope) {
    const long gid = (long)blockIdx.x * blockDim.x + threadIdx.x, nth = (long)gridDim.x * blockDim.x;
    for (long i = gid; i < (long)nv::R * 768; i += nth) { const int r = (int)(i / 768), c = (int)(i % 768), h = c / 192, j = c % 192;
        const float v = bf2f(QB[(size_t)nat2fr(r) * 768 + c]) * (1.0f / C2Q);
        if (j < 128) q[(size_t)r * 768 + c] = v; else q_rope[(size_t)r * 256 + h * 64 + (j - 128)] = v; }
}
__global__ void k_cv_out(const float* outp, const float* outs, int ncols, float* dst) {
    const long gid = (long)blockIdx.x * blockDim.x + threadIdx.x, nth = (long)gridDim.x * blockDim.x;
    for (long i = gid; i < (long)nv::R * ncols; i += nth) { const int r = (int)(i / ncols), c = (int)(i % ncols);
        dst[i] = r < nv::RP ? outp[(size_t)r * ncols + c] : outs[(size_t)(r - nv::RP) * ncols + c]; }
}
}
namespace fk {
__device__ __forceinline__ int fr2nat(int fr) { if (fr < FR_META) return (fr >> 12) * nv::TP + 16 + (fr & 4095); if (fr < FR_META + 16) return fr - FR_META; if (fr < FR_SAMP) return -1; return nv::RP + (fr - FR_SAMP); }
__global__ void k_cv_n2f(const float* src, int lds_, int coff, bf16_t* dst, int ldd, int doff, int ncols) {
    const long gid = (long)blockIdx.x * blockDim.x + threadIdx.x, nth = (long)gridDim.x * blockDim.x;
    for (long i = gid; i < (long)MP * ncols; i += nth) { const int fr = (int)(i / ncols), c = (int)(i % ncols); const int r = fr2nat(fr);
        const float v = r >= 0 ? src[(size_t)r * lds_ + coff + c] : 0.f; dst[(size_t)fr * ldd + doff + c] = (bf16_t)(pk2(v, v) & 0xffffu); }
}
__global__ void __launch_bounds__(512, 2) k_glu(P p) {
    pg8::Gemm g{p.YS, p.Bt_glu, MP, 512, 512}; pg8::StaticOrder S; S.init(MP, 512, gridDim.x, blockIdx.x); EpiGLU E{p};
    pg8::gemm_phase<EpiGLU, pg8::StaticOrder, true, true>((LAS unsigned char*)lds_dyn, g, S, E);
}
__global__ void __launch_bounds__(512, 2) k_out(P p) {
    pg8::Gemm g{p.CAT, p.Bt_out, MP, 1024, 1024}; pg8::StaticOrder S; S.init(MP, 1024, gridDim.x, blockIdx.x); EpiOut E{p};
    pg8::gemm_phase<EpiOut, pg8::StaticOrder, true, true>((LAS unsigned char*)lds_dyn, g, S, E);
}
__global__ void __launch_bounds__(512, 2) k_gu(P p) {
    pg8::Gemm g{p.X1B, p.Bt_gu, MP, 5632, 1024}; pg8::StaticOrder S; S.init(MP, 5632, gridDim.x, blockIdx.x); EpiGU1 E{p};
    pg8::gemm_phase<EpiGU1, pg8::StaticOrder, true, true>((LAS unsigned char*)lds_dyn, g, S, E);
}
__global__ void __launch_bounds__(512, 2) k_conv(P p) { conv_pass(p, get_vcu(), gridDim.x); }
__global__ void __launch_bounds__(512, 2) k_down(P p) {
    pg8::Gemm g{p.H, p.Bt_down, MP, 1024, 2816}; pg8::StaticOrder S; S.init(MP, 1024, gridDim.x, blockIdx.x); EpiDown1 E{p};
    pg8::gemm_phase<EpiDown1, pg8::StaticOrder, true, true>((LAS unsigned char*)lds_dyn, g, S, E);
}
__global__ void __launch_bounds__(512, 2) k_final(P p) { final_pass(p, get_vcu(), gridDim.x); }
}
namespace fk {
__global__ void __launch_bounds__(512, 2) k_attn_prompt(P p) { attn_prompt_phase(p, (LAS unsigned char*)lds_dyn, get_vcu(), gridDim.x); }
}
namespace fk {
__global__ void __launch_bounds__(512, 2) k_attn_sample(P p) { attn_sample_phase(p, (LAS unsigned char*)lds_dyn, get_vcu(), gridDim.x); }
__global__ void __launch_bounds__(512, 2) k_attn_scomb(P p) { attn_sample_combine(p, (LAS unsigned char*)lds_dyn, get_vcu(), gridDim.x); }
}
extern "C" void kernel_launch(void* const* d_in, const int* in_sizes, int n_in,
                              void* d_out, int out_size, void* d_ws, size_t ws_size,
                              hipStream_t stream) {
    static bool attr = false;
    if (!attr) {
        (void)hipFuncSetAttribute((const void*)nv::k_attn, hipFuncAttributeMaxDynamicSharedMemorySize, nv::ATT_LDS_FLOATS * 4);
        (void)hipFuncSetAttribute((const void*)fk::k_prologue, hipFuncAttributeMaxDynamicSharedMemorySize, fk::LDS_BYTES);
        (void)hipFuncSetAttribute((const void*)fk::k_p1, hipFuncAttributeMaxDynamicSharedMemorySize, fk::LDS_BYTES);
        (void)hipFuncSetAttribute((const void*)fk::k_p2a, hipFuncAttributeMaxDynamicSharedMemorySize, fk::LDS_BYTES);
        (void)hipFuncSetAttribute((const void*)fk::k_p2b, hipFuncAttributeMaxDynamicSharedMemorySize, fk::LDS_BYTES);
        (void)hipFuncSetAttribute((const void*)fk::k_glu, hipFuncAttributeMaxDynamicSharedMemorySize, fk::LDS_BYTES);
        (void)hipFuncSetAttribute((const void*)fk::k_out, hipFuncAttributeMaxDynamicSharedMemorySize, fk::LDS_BYTES);
        (void)hipFuncSetAttribute((const void*)fk::k_gu, hipFuncAttributeMaxDynamicSharedMemorySize, fk::LDS_BYTES);
        (void)hipFuncSetAttribute((const void*)fk::k_conv, hipFuncAttributeMaxDynamicSharedMemorySize, fk::LDS_BYTES);
        (void)hipFuncSetAttribute((const void*)fk::k_down, hipFuncAttributeMaxDynamicSharedMemorySize, fk::LDS_BYTES);
        (void)hipFuncSetAttribute((const void*)fk::k_final, hipFuncAttributeMaxDynamicSharedMemorySize, fk::LDS_BYTES);
        (void)hipFuncSetAttribute((const void*)fk::k_attn_prompt, hipFuncAttributeMaxDynamicSharedMemorySize, fk::LDS_BYTES);
        (void)hipFuncSetAttribute((const void*)fk::k_attn_sample, hipFuncAttributeMaxDynamicSharedMemorySize, fk::LDS_BYTES);
        (void)hipFuncSetAttribute((const void*)fk::k_attn_scomb, hipFuncAttributeMaxDynamicSharedMemorySize, fk::LDS_BYTES);
        attr = true;
    }
    float* out = (float*)d_out;
    fk::P p{}; fk::fill_inputs(p, d_in, out); fk::carve(p, (char*)d_ws);
    nv::WS w = nv::carve((float*)((char*)d_ws + ((size_t)1 << 30)));
    hipStream_t st = stream;
    fk::k_prologue<<<256, 512, fk::LDS_BYTES, st>>>(p);
    fk::k_p1<<<256, 512, fk::LDS_BYTES, st>>>(p);
    fk::k_p2a<<<256, 512, fk::LDS_BYTES, st>>>(p);
    fk::k_p2b<<<256, 512, fk::LDS_BYTES, st>>>(p);
    nv::k_setup<<<256, 256, 0, st>>>(w.rope_cos, w.rope_sin, p.a_re, p.a_im, p.log_dt, p.b_re, p.b_im, w.abar_re, w.abar_im, w.bbar_re, w.bbar_im);
    nv::k_embed_norm<<<2048, 256, 0, st>>>(p.x_prompt, p.x_sample, p.meta, p.g_mix, w.x0, w.xn);
    fk::k_cv_bf<<<2048, 256, 0, st>>>(p.U, 512, 0, w.z, nv::IN_W, 0, 512, 1.0f);
    nv::k_s5<<<(nv::BATCH + nv::DEC_BATCH) * nv::S5_GROUPS, 64, 0, st>>>(w.z, w.abar_re, w.abar_im, w.bbar_re, w.bbar_im, p.c_re, p.c_im, p.s5_d, p.st_re, p.st_im, w.ys5a, out);
    fk::k_cv_n2f<<<2048, 256, 0, st>>>(w.ys5a, 512, 0, p.YS, 512, 0, 512);
    fk::k_attn_prompt<<<256, 512, fk::LDS_BYTES, st>>>(p);
    fk::k_attn_sample<<<256, 512, fk::LDS_BYTES, st>>>(p);
    fk::k_attn_scomb<<<256, 512, fk::LDS_BYTES, st>>>(p);
    fk::k_glu<<<256, 512, fk::LDS_BYTES, st>>>(p);
    fk::k_out<<<256, 512, fk::LDS_BYTES, st>>>(p);
    fk::k_gu<<<256, 512, fk::LDS_BYTES, st>>>(p);
    fk::k_conv<<<256, 512, fk::LDS_BYTES, st>>>(p);
    fk::k_down<<<256, 512, fk::LDS_BYTES, st>>>(p);
    fk::k_final<<<256, 512, fk::LDS_BYTES, st>>>(p);
}
```

```cpp
#include <hip/hip_runtime.h>
#include <math.h>
namespace nv {
constexpr int D_MODEL = 1024, BATCH = 4, SEQ = 4096, DEC_BATCH = 128, DEC_SEQ = 8, PAST_LEN = 8192, PAGE_SIZE = 128;
constexpr int N_META = 16, S5_W = 512, S5_GROUP = 16, S5_GROUPS = 32, S5_STATE = 64, MLA_HEADS = 4, QK_NOPE = 128, QK_ROPE = 64, V_HEAD = 128;
constexpr int Q_RANK = 384, KV_RANK = 256, D_FF = 2816, IN_W = 1216, N_PAGES = 64, N_POOL = 10240;
constexpr int TP = N_META + SEQ;
constexpr int RP = BATCH * TP;
constexpr int RS = DEC_BATCH * DEC_SEQ;
constexpr int R = RP + RS;
constexpr float EPS = 1e-6f;
constexpr float ATTN_SCALE = 0.07216878364870322f;
constexpr size_t O_YP = 0, O_YS = O_YP + (size_t)BATCH * SEQ * D_MODEL, O_CKVP = O_YS + (size_t)RS * D_MODEL, O_KRP = O_CKVP + (size_t)RP * KV_RANK,
                 O_SREP = O_KRP + (size_t)RP * QK_ROPE, O_SIMP = O_SREP + BATCH * S5_GROUPS * S5_STATE, O_CONVP = O_SIMP + BATCH * S5_GROUPS * S5_STATE,
                 O_CKVS = O_CONVP + BATCH * 2 * D_FF, O_KRS = O_CKVS + (size_t)RS * KV_RANK, O_SRES = O_KRS + (size_t)RS * QK_ROPE,
                 O_SIMS = O_SRES + DEC_BATCH * S5_GROUPS * S5_STATE, O_CONVS = O_SIMS + DEC_BATCH * S5_GROUPS * S5_STATE, O_END = O_CONVS + (size_t)DEC_BATCH * 2 * D_FF;

}
#define GAS __attribute__((address_space(1)))
#define LAS __attribute__((address_space(3)))
typedef unsigned short bf16;
typedef unsigned v4u __attribute__((ext_vector_type(4)));
typedef float f32x4 __attribute__((ext_vector_type(4)));
typedef short bf16x8 __attribute__((ext_vector_type(8)));
typedef GAS unsigned gu32;
typedef GAS unsigned long long gu64;
#define RLX_AGENT __ATOMIC_RELAXED, __HIP_MEMORY_SCOPE_AGENT
#define LDS_WAIT() asm volatile("s_waitcnt lgkmcnt(0)" ::: "memory")
#define VM_WAIT() asm volatile("s_waitcnt vmcnt(0)" ::: "memory")
__device__ __forceinline__ unsigned long long rt() { return __builtin_amdgcn_s_memrealtime(); }
__device__ __forceinline__ unsigned f2bf(float f) { unsigned u = __builtin_bit_cast(unsigned, f); return (u + 0x7fffu + ((u >> 16) & 1u)) >> 16; }
__device__ __forceinline__ unsigned pk2(float lo, float hi) { return f2bf(lo) | (f2bf(hi) << 16); }

#define XB_TMO      128
#define XB_XCNT(j)  (256  + 64 * (j))
#define XB_XSUB(j)  (1280 + 64 * (j))
#define XB_XGEN(j)  (2304 + 64 * (j))
#define XB_TOP      3328
#define XB_TOPGEN   3392
#define XCD_BAR_WORDS 3456
#define XB_SPIN_CAP (1u << 18)

__device__ __forceinline__ unsigned xb_ld(unsigned* p)              { return __hip_atomic_load(p, __ATOMIC_RELAXED, __HIP_MEMORY_SCOPE_AGENT); }
__device__ __forceinline__ unsigned xb_add(unsigned* p, unsigned v) { return __hip_atomic_fetch_add(p, v, __ATOMIC_RELAXED, __HIP_MEMORY_SCOPE_AGENT); }
__device__ __forceinline__ unsigned xb_xcc_id() { return (unsigned)__builtin_amdgcn_s_getreg((3 << 11) | 20) & 0xFu; }
#define XB_SPIN(cond, bar) do { unsigned _sp = 0; while (cond) { __builtin_amdgcn_s_sleep(1); \
    if ((++_sp & 255u) == 0u) { if (xb_ld(&(bar)[XB_TMO])) break; if (_sp > XB_SPIN_CAP) { atomicAdd(&(bar)[XB_TMO], 1u); break; } } } } while (0)

struct XcdBarrier {
    unsigned* bar; unsigned x;
    volatile LAS unsigned* st;
};

__device__ __forceinline__ XcdBarrier xcd_barrier_post(unsigned* bar, volatile LAS unsigned* st) {
    XcdBarrier b; b.bar = bar; b.x = xb_xcc_id(); b.st = st;
    if (threadIdx.x == 0) (void)xb_add(&bar[XB_XCNT(b.x)], 1u);
    return b;
}
__device__ __forceinline__ void xcd_barrier_complete(unsigned* bar, unsigned x, unsigned& nloc, unsigned& nx) {
    const unsigned G = gridDim.x * gridDim.y * gridDim.z;
    unsigned sum, cnt, mine, sp = 0u;
    for (;;) {
        sum = 0u; cnt = 0u; mine = 0u;
#pragma unroll
        for (unsigned j = 0; j < 16; ++j) { const unsigned c = xb_ld(&bar[XB_XCNT(j)]); sum += c; cnt += (c > 0u) ? 1u : 0u; mine = (j == x) ? c : mine; }
        if (sum == G) break;
        __builtin_amdgcn_s_sleep(1);
        if ((++sp & 255u) == 0u) { if (xb_ld(&bar[XB_TMO])) break; if (sp > XB_SPIN_CAP) { atomicAdd(&bar[XB_TMO], 1u); break; } }
    }
    nloc = mine > 0u ? mine : 1u; nx = cnt > 0u ? cnt : 1u;
}

__device__ __forceinline__ void xcd_barrier(const XcdBarrier& b) {
    asm volatile("s_waitcnt vmcnt(0)" ::: "memory");
    __syncthreads();
    if (threadIdx.x == 0) {
        unsigned* bar = b.bar;
        __builtin_amdgcn_s_waitcnt(0);
        unsigned nloc = b.st[0], nx = b.st[1];
        if (nloc == 0u) { xcd_barrier_complete(bar, b.x, nloc, nx); b.st[0] = nloc; b.st[1] = nx; }
        const unsigned old = xb_add(&bar[XB_XSUB(b.x)], 1u);
        const unsigned gen = old / nloc;
        if (old + 1u == (gen + 1u) * nloc) {
            __builtin_amdgcn_fence(__ATOMIC_RELEASE, "agent");
            asm volatile("s_waitcnt vmcnt(0)" ::: "memory");
            const unsigned og = xb_add(&bar[XB_TOP], 1u);
            const unsigned tg = og / nx;
            if (og + 1u == (tg + 1u) * nx) xb_add(&bar[XB_TOPGEN], 1u);
            else XB_SPIN(xb_ld(&bar[XB_TOPGEN]) == tg, bar);
            __builtin_amdgcn_fence(__ATOMIC_ACQUIRE, "agent");
            xb_add(&bar[XB_XGEN(b.x)], 1u);
            asm volatile("s_waitcnt vmcnt(0)" ::: "memory");
        } else {
            XB_SPIN(xb_ld(&bar[XB_XGEN(b.x)]) == gen, bar);
            __builtin_amdgcn_fence(__ATOMIC_ACQUIRE, "agent");
            asm volatile("s_waitcnt vmcnt(0)" ::: "memory");
        }
    }
    __syncthreads();
}
namespace pg8 {
#define PG8_LAS __attribute__((address_space(3)))
typedef unsigned short bf16_t;
typedef short bf16x8 __attribute__((ext_vector_type(8)));
typedef float f32x4 __attribute__((ext_vector_type(4)));
typedef unsigned u32x4 __attribute__((ext_vector_type(4)));
constexpr int BM = 256, BK = 64, HALF = 128, HTB = HALF * BK * 2  , STAGE_BYTES = 8 * HTB, NXCD = 8, WGM = 8;

__host__ __device__ __forceinline__ int lds_byte(int r, int c) { const int st = (r >> 4) * 2 + (c >> 5), rr = r & 15, cc = c & 31, ob = rr * 64 + cc * 2; return st * 1024 + (ob ^ (((ob >> 9) & 1) << 5)); }
__host__ __device__ __forceinline__ void stage_rc(int b, int& R, int& C) { const int st = b / 1024, sb = b % 1024, swz = sb ^ (((sb >> 9) & 1) << 5); R = (st >> 1) * 16 + swz / 64; C = (st & 1) * 32 + (swz % 64) / 2; }
__host__ __device__ __forceinline__ int perm32(int rho) { const int n = rho >> 4, i = rho & 15; return 8 * (i >> 2) + 4 * n + (i & 3); }

struct Unit { int pm, pn; };
struct Gemm { const bf16_t* A; const bf16_t* Bt; int M, N, K; };

struct StaticOrder {
    int nM, nN, nwg, G, c;
    __host__ __device__ void init(int M, int N, int G_, int c_) { nM = M / BM; nN = N / BM; nwg = nM * nN; G = G_; c = c_; }
    __host__ __device__ bool next(int i, Unit& u) const {
        const long L = (long)i * G + c; if (L >= nwg) return false;
        int wgid = (int)L; { const int q = nwg / NXCD, r = nwg % NXCD, xcd = wgid % NXCD, off = wgid / NXCD; wgid = (xcd < r ? xcd * (q + 1) : r * (q + 1) + (xcd - r) * q) + off; }
        const int nig = WGM * nN, gid = wgid / nig, fm = gid * WGM, gsz = (nM - fm) < WGM ? (nM - fm) : WGM;
        u.pm = fm + ((wgid % nig) % gsz); u.pn = (wgid % nig) / gsz; return true;
    }
    __device__ __forceinline__ void a_ready(const Unit&) const {}
    __device__ __forceinline__ void done(const Unit&) const {}
};

__device__ __forceinline__ unsigned cvt_pk_bf16(float lo, float hi) { unsigned r; asm volatile("v_cvt_pk_bf16_f32 %0, %1, %2" : "=v"(r) : "v"(lo), "v"(hi)); return r; }
typedef float f32x2 __attribute__((ext_vector_type(2)));
__device__ __forceinline__ f32x2 gelu_pk(f32x2 v) {
    const f32x2 av = __builtin_elementwise_abs(v), d = av * 0.2316418882f + 1.0f;
    f32x2 t; t.x = __builtin_amdgcn_rcpf(d.x); t.y = __builtin_amdgcn_rcpf(d.y);
    f32x2 q = t * 0.5307027145f + (-0.7265760135f); q = q * t + 0.7107068705f; q = q * t + (-0.142248368f); q = q * t + 0.127414796f; q = q * t;
    const f32x2 s = (v * v) * (-0.72134752044f);
    f32x2 e; e.x = __builtin_amdgcn_exp2f(s.x); e.y = __builtin_amdgcn_exp2f(s.y);
    const f32x2 m = v * (q * e), r = v - m;
    f32x2 o; o.x = v.x < 0.f ? m.x : r.x; o.y = v.y < 0.f ? m.y : r.y; return o;
}

template <int ACT  > struct EpiBf16 {
    static constexpr bool PERM = true, AFTER_DRAIN = false; static_assert(ACT == 0 || ACT == 1, "EpiBf16: ACT is 0 (none) or 1 (gelu_pk)");
    bf16_t* O; int ldc; const float* bias; int split_cols; size_t split_stride; float scale0;
    __device__ __forceinline__ void operator()(const f32x4 (&acc)[2][2][4][2], const Unit& u, int wr, int wc, int fr, int fq) const {
        const int row0 = u.pm * BM + wr * 64 + fr; int colt = u.pn * BM; bf16_t* base = O;
        float sc = 1.f; if (split_cols) { const int t = colt / split_cols; base += (size_t)t * split_stride; colt -= t * split_cols; if (t == 0) sc = scale0; }
        const int col0 = colt + wc * 32 + 8 * fq, bcol0 = u.pn * BM + wc * 32 + 8 * fq;
        f32x4 bv[2][2];
#pragma unroll
        for (int bj = 0; bj < 2; ++bj)
#pragma unroll
            for (int n = 0; n < 2; ++n) bv[bj][n] = bias ? *(const f32x4*)(bias + bcol0 + bj * HALF + 4 * n) : (f32x4){0.f, 0.f, 0.f, 0.f};
#pragma unroll
        for (int ai = 0; ai < 2; ++ai)
#pragma unroll
            for (int m = 0; m < 4; ++m) { bf16_t* rowp = base + (size_t)(row0 + ai * HALF + m * 16) * ldc + col0;
#pragma unroll
                for (int bj = 0; bj < 2; ++bj) { f32x4 v0 = acc[ai][bj][m][0] + bv[bj][0], v1 = acc[ai][bj][m][1] + bv[bj][1];
                    if (ACT == 1) { f32x2 a = gelu_pk((f32x2){v0[0], v0[1]}), b = gelu_pk((f32x2){v0[2], v0[3]}), c = gelu_pk((f32x2){v1[0], v1[1]}), d = gelu_pk((f32x2){v1[2], v1[3]});
                        v0 = (f32x4){a.x, a.y, b.x, b.y}; v1 = (f32x4){c.x, c.y, d.x, d.y}; }
                    v0 = v0 * sc; v1 = v1 * sc; u32x4 w; w.x = cvt_pk_bf16(v0[0], v0[1]); w.y = cvt_pk_bf16(v0[2], v0[3]); w.z = cvt_pk_bf16(v1[0], v1[1]); w.w = cvt_pk_bf16(v1[2], v1[3]);
                    *(u32x4*)(rowp + bj * HALF) = w; } }
    }
};
template <class Epi, class Sched, bool ALIGN_EPI = false, bool SP2 = false>
__device__ __forceinline__ void gemm_phase(PG8_LAS unsigned char* lds, const Gemm g, const Sched& S, const Epi& E) {
    int tid = threadIdx.x; asm volatile("" : "+v"(tid));
    const int wid = __builtin_amdgcn_readfirstlane(tid >> 6), lane = tid & 63, wr = wid >> 2, wc = wid & 3, fr = lane & 15, fq = lane >> 4;
    const int K = g.K, nt = K / BK;
    unsigned voffA[2], voffB[2];
#pragma unroll
    for (int i = 0; i < 2; ++i) { int R, C; stage_rc(tid * 16 + i * 8192, R, C); const int Rb = Epi::PERM ? ((R & ~31) + perm32(R & 31)) : R;
        voffA[i] = (unsigned)(R * K + C) * 2u; voffB[i] = (unsigned)(Rb * K + C) * 2u; }
    const size_t kstep = (size_t)(BK * 2);
    const size_t hstep = (size_t)HALF * K * 2;
    const size_t tstep = 2 * hstep;
    const unsigned ldsw = (unsigned)wid * 1024u;
    const int aoff = lds_byte(wr * 64 + fr, fq * 8), boff = lds_byte(wc * 32 + fr, fq * 8);
#define PG8_SA(b, h) (((b) * 2 + (h)) * HTB)
#define PG8_SB(b, h) ((4 + (b) * 2 + (h)) * HTB)
#define PG8_STAGE(bufoff, gbase, voff) do { _Pragma("unroll") for (int _i = 0; _i < 2; ++_i) \
        __builtin_amdgcn_global_load_lds((const unsigned*)((const char*)(gbase) + (voff)[_i]), (PG8_LAS unsigned*)(lds + (bufoff) + ldsw + _i * 8192), 16, 0, 0); } while (0)
#define PG8_LDA(dst, b, h) do { _Pragma("unroll") for (int m = 0; m < 4; ++m) _Pragma("unroll") for (int k = 0; k < 2; ++k) dst[m][k] = *(const PG8_LAS bf16x8*)(lds + PG8_SA(b, h) + aoff + m * 2048 + k * 1024); } while (0)
#define PG8_LDB(dst, b, h) do { _Pragma("unroll") for (int n = 0; n < 2; ++n) _Pragma("unroll") for (int k = 0; k < 2; ++k) dst[n][k] = *(const PG8_LAS bf16x8*)(lds + PG8_SB(b, h) + boff + n * 2048 + k * 1024); } while (0)
#define PG8_MMA(ai, bj, At, Bt) do { __builtin_amdgcn_s_setprio(1); _Pragma("unroll") for (int m = 0; m < 4; ++m) _Pragma("unroll") for (int n = 0; n < 2; ++n) _Pragma("unroll") for (int k = 0; k < 2; ++k) \
        acc[ai][bj][m][n] = __builtin_amdgcn_mfma_f32_16x16x32_bf16(Bt[n][k], At[m][k], acc[ai][bj][m][n], 0, 0, 0); __builtin_amdgcn_s_setprio(0); } while (0)
#define PG8_WAIT_V(n) asm volatile("s_waitcnt vmcnt(" #n ")" ::: "memory")
#define PG8_WAIT_L(n) asm volatile("s_waitcnt lgkmcnt(" #n ")" ::: "memory")
#define PG8_BAR __builtin_amdgcn_s_barrier()
#define PG8_SCHED __builtin_amdgcn_sched_barrier(0)
    Unit cur, nxt; int ui = 0;
    if (!S.next(0, cur)) return;
    f32x4 acc[2][2][4][2];
#pragma unroll
    for (int a = 0; a < 2; ++a)
#pragma unroll
        for (int b = 0; b < 2; ++b)
#pragma unroll
            for (int m = 0; m < 4; ++m)
#pragma unroll
                for (int n = 0; n < 2; ++n) acc[a][b][m][n] = (f32x4){0.f, 0.f, 0.f, 0.f};
    bf16x8 At[4][2], B0[2][2], B1[2][2];
    const char* cA = (const char*)g.A + (size_t)cur.pm * tstep; const char* cB = (const char*)g.Bt + (size_t)cur.pn * tstep;
    S.a_ready(cur);
    if constexpr (SP2) {
        PG8_STAGE(PG8_SB(0, 0), cB, voffB); PG8_STAGE(PG8_SB(0, 1), cB + hstep, voffB); PG8_STAGE(PG8_SA(0, 0), cA, voffA); PG8_STAGE(PG8_SA(0, 1), cA + hstep, voffA);
        if (wr == 1) PG8_BAR;
        PG8_WAIT_V(2); PG8_BAR;
        PG8_STAGE(PG8_SB(1, 0), cB + kstep, voffB); PG8_STAGE(PG8_SA(1, 0), cA + kstep, voffA); PG8_STAGE(PG8_SB(1, 1), cB + hstep + kstep, voffB);
        PG8_WAIT_V(6); PG8_BAR;
    } else {
        PG8_STAGE(PG8_SB(0, 0), cB, voffB); PG8_STAGE(PG8_SA(0, 0), cA, voffA); PG8_STAGE(PG8_SB(0, 1), cB + hstep, voffB); PG8_STAGE(PG8_SA(0, 1), cA + hstep, voffA);
        if (wr == 1) PG8_BAR;
        PG8_WAIT_V(4); PG8_BAR;
        PG8_STAGE(PG8_SB(1, 0), cB + kstep, voffB); PG8_STAGE(PG8_SA(1, 0), cA + kstep, voffA); PG8_STAGE(PG8_SB(1, 1), cB + hstep + kstep, voffB);
        PG8_WAIT_V(6); PG8_BAR;
    }
    for (;;) {
        const bool has_next = S.next(ui + 1, nxt);
        const char* nA = has_next ? (const char*)g.A + (size_t)nxt.pm * tstep : cA; const char* nB = has_next ? (const char*)g.Bt + (size_t)nxt.pn * tstep : cB;
        for (int t = 0; t < nt; t += 2) {
            const bool last = (t == nt - 2);
            const char* a1 = cA + (size_t)(t + 1) * kstep;
            const char* a2 = last ? nA : cA + (size_t)(t + 2) * kstep; const char* b2 = last ? nB : cB + (size_t)(t + 2) * kstep;
            const char* a3 = a2 + kstep; const char* b3 = b2 + kstep;
            if (last && has_next) S.a_ready(nxt);
            if constexpr (SP2) {
            PG8_LDB(B0, 0, 0); PG8_LDB(B1, 0, 1); PG8_SCHED; PG8_LDA(At, 0, 0); PG8_STAGE(PG8_SA(1, 1), a1 + hstep, voffA);
            PG8_WAIT_V(8); PG8_WAIT_L(0); PG8_BAR; PG8_MMA(0, 0, At, B0); PG8_MMA(0, 1, At, B1); PG8_BAR; PG8_SCHED;
            PG8_LDA(At, 0, 1); PG8_STAGE(PG8_SB(0, 0), b2, voffB); PG8_STAGE(PG8_SB(0, 1), b2 + hstep, voffB); PG8_STAGE(PG8_SA(0, 0), a2, voffA);
            PG8_WAIT_V(8); PG8_WAIT_L(0); PG8_BAR; PG8_MMA(1, 0, At, B0); PG8_MMA(1, 1, At, B1); PG8_BAR; PG8_SCHED;
            PG8_LDB(B0, 1, 0); PG8_LDB(B1, 1, 1); PG8_SCHED; PG8_LDA(At, 1, 0); PG8_STAGE(PG8_SA(0, 1), a2 + hstep, voffA);
            PG8_WAIT_V(8); PG8_WAIT_L(0); PG8_BAR; PG8_MMA(0, 0, At, B0); PG8_MMA(0, 1, At, B1); PG8_BAR; PG8_SCHED;
            PG8_LDA(At, 1, 1); PG8_STAGE(PG8_SB(1, 0), b3, voffB); PG8_STAGE(PG8_SB(1, 1), b3 + hstep, voffB); PG8_STAGE(PG8_SA(1, 0), a3, voffA);
            PG8_WAIT_V(8); PG8_WAIT_L(0); PG8_BAR; PG8_MMA(1, 0, At, B0); PG8_MMA(1, 1, At, B1); PG8_BAR; PG8_SCHED;
            } else {
            PG8_LDB(B0, 0, 0); PG8_SCHED; PG8_LDA(At, 0, 0); PG8_STAGE(PG8_SA(1, 1), a1 + hstep, voffA);
            PG8_WAIT_L(8); PG8_BAR; PG8_WAIT_L(0); PG8_MMA(0, 0, At, B0); PG8_BAR; PG8_SCHED;
            PG8_LDB(B1, 0, 1); PG8_STAGE(PG8_SB(0, 0), b2, voffB);
            PG8_BAR; PG8_WAIT_L(0); PG8_MMA(0, 1, At, B1); PG8_BAR;
            PG8_LDA(At, 0, 1); PG8_STAGE(PG8_SA(0, 0), a2, voffA);
            PG8_BAR; PG8_WAIT_L(0); PG8_MMA(1, 0, At, B0); PG8_BAR; PG8_SCHED;
            PG8_STAGE(PG8_SB(0, 1), b2 + hstep, voffB);
            PG8_WAIT_V(6); PG8_BAR; PG8_MMA(1, 1, At, B1); PG8_BAR;
            PG8_LDB(B0, 1, 0); PG8_SCHED; PG8_LDA(At, 1, 0); PG8_STAGE(PG8_SA(0, 1), a2 + hstep, voffA);
            PG8_WAIT_L(8); PG8_BAR; PG8_WAIT_L(0); PG8_MMA(0, 0, At, B0); PG8_BAR; PG8_SCHED;
            PG8_LDB(B1, 1, 1); PG8_STAGE(PG8_SB(1, 0), b3, voffB);
            PG8_BAR; PG8_WAIT_L(0); PG8_MMA(0, 1, At, B1); PG8_BAR;
            PG8_LDA(At, 1, 1); PG8_STAGE(PG8_SA(1, 0), a3, voffA);
            PG8_BAR; PG8_WAIT_L(0); PG8_MMA(1, 0, At, B0); PG8_BAR; PG8_SCHED;
            PG8_STAGE(PG8_SB(1, 1), b3 + hstep, voffB);
            PG8_WAIT_V(6); PG8_BAR; PG8_MMA(1, 1, At, B1); PG8_BAR;
            }
        }
        if constexpr (ALIGN_EPI) { if (wr == 0) PG8_BAR; }
        if constexpr (!Epi::AFTER_DRAIN) { E(acc, cur, wr, wc, fr, fq); S.done(cur); }
        if (!has_next) break;
#pragma unroll
        for (int a = 0; a < 2; ++a)
#pragma unroll
            for (int b = 0; b < 2; ++b)
#pragma unroll
                for (int m = 0; m < 4; ++m)
#pragma unroll
                    for (int n = 0; n < 2; ++n) acc[a][b][m][n] = (f32x4){0.f, 0.f, 0.f, 0.f};
        cur = nxt; cA = nA; cB = nB; ++ui;
        if constexpr (ALIGN_EPI) { if (wr == 1) PG8_BAR; }
    }
    PG8_WAIT_V(0);
    if constexpr (!ALIGN_EPI) { if (wr == 0) PG8_BAR; }
    PG8_BAR;
    if constexpr (Epi::AFTER_DRAIN) { E.fused(acc, cur, wr, wc, fr, fq, lds, wid, lane); S.done(cur); }
#undef PG8_SA
#undef PG8_SB
#undef PG8_STAGE
#undef PG8_LDA
#undef PG8_LDB
#undef PG8_MMA
#undef PG8_WAIT_V
#undef PG8_WAIT_L
#undef PG8_BAR
#undef PG8_SCHED
}
}
namespace fk {
using pg8::bf16_t; using pg8::f32x4; using pg8::u32x4; using pg8::Unit;
typedef unsigned u32x2 __attribute__((ext_vector_type(2)));
constexpr int MP = 17664;
constexpr int FR_META = 16384, FR_SAMP = 16640;
constexpr int TPK = nv::TP;
constexpr float EPS = 1e-6f;
constexpr float C2Q = 0.07216878364870322f * 1.4426950408889634f;
constexpr int NTHREADS = 512, NWAVES = 8;

struct P {
    const float *x_prompt, *x_sample, *cache_ckv, *cache_kr, *st_re, *st_im, *st_conv; const int* page_table;
    const float *meta, *g_mix, *w_in, *g_q, *w_uq, *g_kv, *w_uk, *w_uv, *a_re, *a_im, *log_dt, *b_re, *b_im, *c_re, *c_im, *s5_d, *w_glu, *w_out, *g_ffn, *w_gate, *w_up, *conv_w, *conv_b, *w_down, *g_final;
    float* out;
    unsigned* ctl;
    bf16_t *Bt_in, *Bt_uq, *Bt_kv, *Bt_glu, *Bt_out, *Bt_gu, *Bt_down;
    float *rope_cos, *rope_sin, *abar_re, *abar_im, *bbar_re, *bbar_im;
    bf16_t *XN, *U, *CQ, *CKVB, *QB, *KB, *VB, *YS, *CAT, *X1B, *H, *UPB;
    float *CKVF, *SSQKV, *SSQQ, *X1, *SSQ1, *GATE, *X2, *APART;
};
struct Carver { char* p; template <class T> T* take(size_t n) { T* r = (T*)p; p += (n * sizeof(T) + 255) / 256 * 256; return r; } };
inline void carve(P& q, char* base) {
    Carver c{base};
    q.ctl = c.take<unsigned>(1 << 18);
    q.Bt_in = c.take<bf16_t>((size_t)1280 * 1024); q.Bt_uq = c.take<bf16_t>((size_t)768 * 384); q.Bt_kv = c.take<bf16_t>((size_t)1024 * 256);
    q.Bt_glu = c.take<bf16_t>((size_t)512 * 512); q.Bt_out = c.take<bf16_t>((size_t)1024 * 1024); q.Bt_gu = c.take<bf16_t>((size_t)5632 * 1024); q.Bt_down = c.take<bf16_t>((size_t)1024 * 2816);
    q.rope_cos = c.take<float>(4120 * 32); q.rope_sin = c.take<float>(4120 * 32); q.abar_re = c.take<float>(2048); q.abar_im = c.take<float>(2048); q.bbar_re = c.take<float>(32768); q.bbar_im = c.take<float>(32768);
    q.XN = c.take<bf16_t>((size_t)MP * 1024); q.U = c.take<bf16_t>((size_t)MP * 512); q.CQ = c.take<bf16_t>((size_t)MP * 384); q.CKVB = c.take<bf16_t>((size_t)MP * 256);
    q.QB = c.take<bf16_t>((size_t)MP * 768); q.KB = c.take<bf16_t>((size_t)MP * 768); q.VB = c.take<bf16_t>((size_t)MP * 512); q.YS = c.take<bf16_t>((size_t)MP * 512);
    q.CAT = c.take<bf16_t>((size_t)MP * 1024); q.X1B = c.take<bf16_t>((size_t)MP * 1024); q.H = c.take<bf16_t>((size_t)MP * 2816); q.UPB = c.take<bf16_t>((size_t)MP * 2816);
    q.CKVF = c.take<float>((size_t)MP * 256); q.SSQKV = c.take<float>((size_t)MP * 4); q.SSQQ = c.take<float>((size_t)MP * 8); q.X1 = c.take<float>((size_t)MP * 1024);
    q.SSQ1 = c.take<float>((size_t)MP * 16); q.GATE = c.take<float>((size_t)MP * 2816); q.X2 = c.take<float>((size_t)MP * 1024); q.APART = c.take<float>((size_t)256 * (32 * 256 + 64));
}
inline void fill_inputs(P& q, void* const* d_in, float* out) {
    q.x_prompt = (const float*)d_in[0]; q.x_sample = (const float*)d_in[1]; q.cache_ckv = (const float*)d_in[2]; q.cache_kr = (const float*)d_in[3];
    q.st_re = (const float*)d_in[4]; q.st_im = (const float*)d_in[5]; q.st_conv = (const float*)d_in[6]; q.page_table = (const int*)d_in[7];
    q.meta = (const float*)d_in[8]; q.g_mix = (const float*)d_in[9]; q.w_in = (const float*)d_in[10]; q.g_q = (const float*)d_in[11];
    q.w_uq = (const float*)d_in[12]; q.g_kv = (const float*)d_in[13]; q.w_uk = (const float*)d_in[14]; q.w_uv = (const float*)d_in[15];
    q.a_re = (const float*)d_in[16]; q.a_im = (const float*)d_in[17]; q.log_dt = (const float*)d_in[18]; q.b_re = (const float*)d_in[19];
    q.b_im = (const float*)d_in[20]; q.c_re = (const float*)d_in[21]; q.c_im = (const float*)d_in[22]; q.s5_d = (const float*)d_in[23];
    q.w_glu = (const float*)d_in[24]; q.w_out = (const float*)d_in[25]; q.g_ffn = (const float*)d_in[26]; q.w_gate = (const float*)d_in[27];
    q.w_up = (const float*)d_in[28]; q.conv_w = (const float*)d_in[29]; q.conv_b = (const float*)d_in[30]; q.w_down = (const float*)d_in[31];
    q.g_final = (const float*)d_in[32]; q.out = out;
}

__device__ __forceinline__ int fresh_tid() { int t = threadIdx.x; asm volatile("" : "+v"(t)); return t; }
__device__ __forceinline__ int fr_posidx(int fr) { return fr < FR_META ? (fr & 4095) + 16 : (fr < FR_SAMP ? (fr - FR_META) & 15 : TPK + ((fr - FR_SAMP) & 7)); }
__device__ __forceinline__ unsigned pk2(float lo, float hi) { return pg8::cvt_pk_bf16(lo, hi); }
__device__ __forceinline__ float bf2f(bf16_t v) { return __uint_as_float((unsigned)v << 16); }
__device__ __forceinline__ float wsum(float v) {
#pragma unroll
    for (int o = 1; o < 64; o <<= 1) v += __shfl_xor(v, o);
    return v;
}

__device__ __forceinline__ void conv_item(const float* W, int ldw, int c0, const float* gk, int k0, bf16_t* Bt, int K, int n0, LAS float* scr, int lane) {
#pragma unroll 8
    for (int i = 0; i < 32; ++i) { const int kk = 2 * i + (lane >> 5); float v = 0.f;
        if (c0 >= 0) { v = W[(size_t)(k0 + kk) * ldw + c0 + (lane & 31)]; if (gk) v *= gk[k0 + kk]; }
        scr[kk * 33 + (lane & 31)] = v; }
    LDS_WAIT(); asm volatile("" ::: "memory");
    const int c = lane & 7;
#pragma unroll
    for (int j = 0; j < 4; ++j) { const int n = (lane >> 3) + 8 * j; const LAS float* s = scr + (8 * c) * 33 + n;
        v4u o; o.x = pk2(s[0 * 33], s[1 * 33]); o.y = pk2(s[2 * 33], s[3 * 33]); o.z = pk2(s[4 * 33], s[5 * 33]); o.w = pk2(s[6 * 33], s[7 * 33]);
        *(GAS v4u*)(Bt + (size_t)(n0 + n) * K + k0 + 8 * c) = o; }
    LDS_WAIT(); asm volatile("" ::: "memory");
}
__device__ __forceinline__ int in_colmap(int nb) {
    if (nb < 16) return 32 * nb;
    if (nb < 24) return 896 + 32 * (nb - 16);
    if (nb < 32) return 512 + 32 * (nb - 24);
    if (nb == 32) return 1152;
    if (nb < 36) return 768 + 32 * (nb - 33);
    if (nb == 36) return 1184;
    if (nb == 37) return 864;
    return -1;
}
__device__ __forceinline__ int uq_colmap(int nb) {
    if (nb < 16) return 192 * (nb >> 2) + 32 * (nb & 3);
    if (nb < 20) return 192 * (nb - 16) + 128;
    return 192 * (nb - 20) + 160;
}
constexpr int IT_IN = 40 * 16, IT_UQ = 24 * 6, IT_KV = 32 * 4, IT_GLU = 16 * 8, IT_OUT = 32 * 16, IT_GU = 176 * 16, IT_DN = 32 * 44;
constexpr int IT_TOTAL = IT_IN + IT_UQ + IT_KV + IT_GLU + IT_OUT + IT_GU + IT_DN;
__device__ __forceinline__ void prologue(const P& p, LAS unsigned char* lds, int vcu, int G) {
    const int tid = fresh_tid(), lane = tid & 63, wave = tid >> 6;
    LAS float* scr = (LAS float*)(lds + wave * 16384);
    const int gw = vcu * NWAVES + wave, NGW = G * NWAVES;
    for (int it = gw; it < IT_TOTAL; it += NGW) {
        int r = it;
        if (r < IT_IN) { const int nb = r % 40, kb = r / 40; conv_item(p.w_in, 1216, in_colmap(nb), nullptr, 64 * kb, p.Bt_in, 1024, 32 * nb, scr, lane); continue; } r -= IT_IN;
        if (r < IT_UQ) { const int nb = r % 24, kb = r / 24; conv_item(p.w_uq, 768, uq_colmap(nb), p.g_q, 64 * kb, p.Bt_uq, 384, 32 * nb, scr, lane); continue; } r -= IT_UQ;
        if (r < IT_KV) { const int nb = r % 32, kb = r / 32; conv_item(nb < 16 ? p.w_uk : p.w_uv, 512, 32 * (nb & 15), p.g_kv, 64 * kb, p.Bt_kv, 256, 32 * nb, scr, lane); continue; } r -= IT_KV;
        if (r < IT_GLU) { const int nb = r % 16, kb = r / 16; conv_item(p.w_glu, 512, 32 * nb, nullptr, 64 * kb, p.Bt_glu, 512, 32 * nb, scr, lane); continue; } r -= IT_GLU;
        if (r < IT_OUT) { const int nb = r % 32, kb = r / 32; conv_item(p.w_out, 1024, 32 * nb, nullptr, 64 * kb, p.Bt_out, 1024, 32 * nb, scr, lane); continue; } r -= IT_OUT;
        if (r < IT_GU) { const int nb = r % 176, kb = r / 176, pn = nb >> 3, nl = nb & 7;
            conv_item(nl < 4 ? p.w_gate : p.w_up, 2816, 128 * pn + 32 * (nl & 3), p.g_ffn, 64 * kb, p.Bt_gu, 1024, 32 * nb, scr, lane); continue; } r -= IT_GU;
        { const int nb = r % 32, kb = r / 32; conv_item(p.w_down, 1024, 32 * nb, nullptr, 64 * kb, p.Bt_down, 2816, 32 * nb, scr, lane); }
    }
    for (int fr = gw; fr < MP; fr += NGW) {
        const float* src = nullptr;
        if (fr < FR_META) src = p.x_prompt + (size_t)fr * 1024;
        else if (fr < FR_META + 16) src = p.meta + (size_t)(fr - FR_META) * 1024;
        else if (fr >= FR_SAMP) src = p.x_sample + (size_t)(fr - FR_SAMP) * 1024;
        GAS unsigned long long* o8 = (GAS unsigned long long*)(p.XN + (size_t)fr * 1024) + lane;
        if (!src) {
#pragma unroll
            for (int j = 0; j < 4; ++j) o8[64 * j] = 0ull;
            continue; }
        const GAS f32x4* xr = (const GAS f32x4*)src + lane; const GAS f32x4* gr = (const GAS f32x4*)p.g_mix + lane;
        f32x4 v[4]; float s = 0.f;
#pragma unroll
        for (int j = 0; j < 4; ++j) { v[j] = xr[64 * j]; s += (v[j].x * v[j].x + v[j].y * v[j].y) + (v[j].z * v[j].z + v[j].w * v[j].w); }
        const float rs = 1.0f / sqrtf(wsum(s) * (1.0f / 1024.0f) + EPS);
#pragma unroll
        for (int j = 0; j < 4; ++j) { const f32x4 g = gr[64 * j]; const f32x4 y = v[j] * rs * g;
            o8[64 * j] = (unsigned long long)pk2(y.x, y.y) | ((unsigned long long)pk2(y.z, y.w) << 32); }
    }
    const int gid = vcu * NTHREADS + tid, nth = G * NTHREADS;
    for (int i = gid; i < 4120 * 32; i += nth) {
        const int pi = i >> 5, f = i & 31; const int pos = pi < TPK ? pi : nv::PAST_LEN + (pi - TPK);
        const double inv = pow(10000.0, -(double)f / 32.0), ang = (double)pos * inv;
        p.rope_cos[i] = (float)cos(ang); p.rope_sin[i] = (float)sin(ang);
    }
    for (int i = gid; i < 2048; i += nth) {
        const int g = i >> 6;
        const double dt = exp((double)p.log_dt[g]), ar = p.a_re[i], ai = p.a_im[i];
        const double mag = exp(dt * ar), cr = mag * cos(dt * ai), ci = mag * sin(dt * ai);
        const double nr = cr - 1.0, ni = ci, den = ar * ar + ai * ai;
        const double fr_ = (nr * ar + ni * ai) / den, fi = (ni * ar - nr * ai) / den;
        p.abar_re[i] = (float)cr; p.abar_im[i] = (float)ci;
        for (int j = 0; j < 16; ++j) { const double br = p.b_re[i * 16 + j], bi = p.b_im[i * 16 + j];
            p.bbar_re[i * 16 + j] = (float)(fr_ * br - fi * bi); p.bbar_im[i * 16 + j] = (float)(fr_ * bi + fi * br); }
    }
}

__device__ __forceinline__ void st_bf4(bf16_t* dst, f32x4 v) { u32x2 w; w.x = pk2(v[0], v[1]); w.y = pk2(v[2], v[3]); *(u32x2*)dst = w; }
__device__ __forceinline__ float sq4(f32x4 v) { return (v[0] * v[0] + v[1] * v[1]) + (v[2] * v[2] + v[3] * v[3]); }

struct EpiIn {
    static constexpr bool PERM = false, AFTER_DRAIN = false;
    P p;
    __device__ __forceinline__ void operator()(const f32x4 (&acc)[2][2][4][2], const Unit& u, int wr, int wc, int fr, int fq) const {
        { const int t_ = fresh_tid(); fr = t_ & 15; fq = (t_ >> 4) & 3; }
        const int pm = u.pm, pn = u.pn;
#pragma unroll
        for (int ai = 0; ai < 2; ++ai)
#pragma unroll
            for (int m = 0; m < 4; ++m) {
                const int row = pm * 256 + ai * 128 + wr * 64 + m * 16 + fr;
                if (pn < 2) {
#pragma unroll
                    for (int bj = 0; bj < 2; ++bj)
#pragma unroll
                        for (int n = 0; n < 2; ++n) st_bf4(p.U + (size_t)row * 512 + pn * 256 + bj * 128 + wc * 32 + n * 16 + 4 * fq, acc[ai][bj][m][n]);
                } else if (pn == 2 || pn == 3) {
                    float s = 0.f;
#pragma unroll
                    for (int bj = 0; bj < 2; ++bj)
#pragma unroll
                        for (int n = 0; n < 2; ++n) { const f32x4 v = acc[ai][bj][m][n]; s += sq4(v); const int c = bj * 128 + wc * 32 + n * 16 + 4 * fq;
                            if (pn == 2) { *(f32x4*)(p.CKVF + (size_t)row * 256 + c) = v; st_bf4(p.CKVB + (size_t)row * 256 + c, v); }
                            else st_bf4(p.CQ + (size_t)row * 384 + c, v); }
                    s += __shfl_xor(s, 16); s += __shfl_xor(s, 32);
                    if (fq == 0) { if (pn == 2) p.SSQKV[(size_t)row * 4 + wc] = s; else p.SSQQ[(size_t)row * 8 + wc] = s; }
                } else {
                    if (wc == 0) {
                        const int pi = fr_posidx(row);
#pragma unroll
                        for (int n = 0; n < 2; ++n) { const int i = n * 16 + 4 * fq;
                            const f32x4 c = *(const f32x4*)(p.rope_cos + pi * 32 + i), s = *(const f32x4*)(p.rope_sin + pi * 32 + i);
                            const f32x4 x1 = acc[ai][0][m][n], x2 = acc[ai][1][m][n];
                            const f32x4 y1 = x1 * c - x2 * s, y2 = x1 * s + x2 * c;
                            if (pm < 64) { const int b = row >> 12, tq = row & 4095; float* o = p.out + nv::O_KRP + ((size_t)b * TPK + 16 + tq) * 64 + i; *(f32x4*)o = y1; *(f32x4*)(o + 32) = y2; }
                            else if (pm == 64) { if (row < FR_META + 16) { const int t = row - FR_META;
#pragma unroll
                                    for (int b = 0; b < 4; ++b) { float* o = p.out + nv::O_KRP + ((size_t)b * TPK + t) * 64 + i; *(f32x4*)o = y1; *(f32x4*)(o + 32) = y2; } } }
                            else { float* o = p.out + nv::O_KRS + (size_t)(row - FR_SAMP) * 64 + i; *(f32x4*)o = y1; *(f32x4*)(o + 32) = y2; }
                            if (pm <= 64) {
#pragma unroll
                                for (int h = 0; h < 4; ++h) { bf16_t* kb = p.KB + ((size_t)row * 4 + h) * 192 + 128 + i; st_bf4(kb, y1); st_bf4(kb + 32, y2); } }
                        }
                        if (fq == 0) p.SSQQ[(size_t)row * 8 + 4] = 0.f;
                    } else {
                        float s = 0.f;
#pragma unroll
                        for (int n = 0; n < 2; ++n) { const f32x4 v = acc[ai][0][m][n]; s += sq4(v); st_bf4(p.CQ + (size_t)row * 384 + 256 + 32 * (wc - 1) + n * 16 + 4 * fq, v); }
                        if (wc == 1) {
#pragma unroll
                            for (int n = 0; n < 2; ++n) { const f32x4 v = acc[ai][1][m][n]; s += sq4(v); st_bf4(p.CQ + (size_t)row * 384 + 352 + n * 16 + 4 * fq, v); } }
                        s += __shfl_xor(s, 16); s += __shfl_xor(s, 32);
                        if (fq == 0) p.SSQQ[(size_t)row * 8 + 4 + wc] = s;
                    }
                }
                asm volatile("" ::: "memory");
            }
    }
};
__device__ __forceinline__ float rstd_q(const P& p, int row) { const f32x4 a = *(const f32x4*)(p.SSQQ + (size_t)row * 8), b = *(const f32x4*)(p.SSQQ + (size_t)row * 8 + 4);
    return 1.0f / sqrtf(((a[0] + a[1]) + (a[2] + a[3]) + (b[0] + b[1]) + (b[2] + b[3])) * (1.0f / 384.0f) + EPS); }
__device__ __forceinline__ float rstd_kv(const P& p, int row) { const f32x4 a = *(const f32x4*)(p.SSQKV + (size_t)row * 4);
    return 1.0f / sqrtf(((a[0] + a[1]) + (a[2] + a[3])) * (1.0f / 256.0f) + EPS); }

struct EpiQ {
    static constexpr bool PERM = false, AFTER_DRAIN = false;
    P p;
    __device__ __forceinline__ void operator()(const f32x4 (&acc)[2][2][4][2], const Unit& u, int wr, int wc, int fr, int fq) const {
        { const int t_ = fresh_tid(); fr = t_ & 15; fq = (t_ >> 4) & 3; }
        const int pm = u.pm, pn = u.pn;
#pragma unroll
        for (int ai = 0; ai < 2; ++ai)
#pragma unroll
            for (int m = 0; m < 4; ++m) {
                const int row = pm * 256 + ai * 128 + wr * 64 + m * 16 + fr;
                const float rs = rstd_q(p, row) * C2Q;
                if (pn < 2) {
#pragma unroll
                    for (int bj = 0; bj < 2; ++bj)
#pragma unroll
                        for (int n = 0; n < 2; ++n) st_bf4(p.QB + ((size_t)row * 4 + 2 * pn + bj) * 192 + wc * 32 + n * 16 + 4 * fq, acc[ai][bj][m][n] * rs);
                } else {
                    const int pi = fr_posidx(row);
#pragma unroll
                    for (int n = 0; n < 2; ++n) { const int i = n * 16 + 4 * fq;
                        const f32x4 c = *(const f32x4*)(p.rope_cos + pi * 32 + i), s = *(const f32x4*)(p.rope_sin + pi * 32 + i);
                        const f32x4 x1 = acc[ai][0][m][n] * rs, x2 = acc[ai][1][m][n] * rs;
                        bf16_t* q = p.QB + ((size_t)row * 4 + wc) * 192 + 128 + i; st_bf4(q, x1 * c - x2 * s); st_bf4(q + 32, x1 * s + x2 * c);
                        asm volatile("" ::: "memory"); }
                }
                asm volatile("" ::: "memory");
            }
    }
};
struct EpiKV {
    static constexpr bool PERM = false, AFTER_DRAIN = false;
    P p;
    __device__ __forceinline__ void operator()(const f32x4 (&acc)[2][2][4][2], const Unit& u, int wr, int wc, int fr, int fq) const {
        { const int t_ = fresh_tid(); fr = t_ & 15; fq = (t_ >> 4) & 3; }
        const int pm = u.pm, pn = u.pn;
#pragma unroll
        for (int ai = 0; ai < 2; ++ai)
#pragma unroll
            for (int m = 0; m < 4; ++m) {
                const int row = pm * 256 + ai * 128 + wr * 64 + m * 16 + fr;
                const float rs = rstd_kv(p, row);
#pragma unroll
                for (int bj = 0; bj < 2; ++bj)
#pragma unroll
                    for (int n = 0; n < 2; ++n) { const int j = wc * 32 + n * 16 + 4 * fq; const f32x4 v = acc[ai][bj][m][n] * rs;
                        if (pn < 2) st_bf4(p.KB + ((size_t)row * 4 + 2 * pn + bj) * 192 + j, v);
                        else st_bf4(p.VB + ((size_t)row * 4 + 2 * (pn - 2) + bj) * 128 + j, v); }
                asm volatile("" ::: "memory");
            }
    }
};
__device__ __forceinline__ void ckv_fixup(const P& p, int vcu, int G) {
    const int tid = fresh_tid(), lane = tid & 63, wave = tid >> 6; const int gw = vcu * NWAVES + wave, NGW = G * NWAVES;
    const f32x4 g = *(const f32x4*)(p.g_kv + 4 * lane);
    for (int fr = gw; fr < MP; fr += NGW) {
        if (fr >= FR_META + 16 && fr < FR_SAMP) continue;
        const float rs = rstd_kv(p, fr); const f32x4 v = *(const f32x4*)(p.CKVF + (size_t)fr * 256 + 4 * lane) * rs * g;
        if (fr < FR_META) { const int b = fr >> 12, tq = fr & 4095; *(f32x4*)(p.out + nv::O_CKVP + ((size_t)b * TPK + 16 + tq) * 256 + 4 * lane) = v; }
        else if (fr < FR_SAMP) { const int t = fr - FR_META;
#pragma unroll
            for (int b = 0; b < 4; ++b) *(f32x4*)(p.out + nv::O_CKVP + ((size_t)b * TPK + t) * 256 + 4 * lane) = v; }
        else *(f32x4*)(p.out + nv::O_CKVS + (size_t)(fr - FR_SAMP) * 256 + 4 * lane) = v;
    }
}
}
namespace fk {
__device__ __forceinline__ const float* x0_row(const P& p, int fr) {
    if (fr < FR_META) return p.x_prompt + (size_t)fr * 1024;
    if (fr < FR_SAMP) return p.meta + (size_t)((fr - FR_META) & 15) * 1024;
    return p.x_sample + (size_t)(fr - FR_SAMP) * 1024;
}
struct EpiGLU {
    static constexpr bool PERM = false, AFTER_DRAIN = false;
    P p;
    __device__ __forceinline__ void operator()(const f32x4 (&acc)[2][2][4][2], const Unit& u, int wr, int wc, int fr, int fq) const {
        { const int t_ = fresh_tid(); fr = t_ & 15; fq = (t_ >> 4) & 3; }
#pragma unroll
        for (int ai = 0; ai < 2; ++ai)
#pragma unroll
            for (int m = 0; m < 4; ++m) {
                const int row = u.pm * 256 + ai * 128 + wr * 64 + m * 16 + fr;
#pragma unroll
                for (int bj = 0; bj < 2; ++bj)
#pragma unroll
                    for (int n = 0; n < 2; ++n) { const int c = u.pn * 256 + bj * 128 + wc * 32 + n * 16 + 4 * fq;
                        const u32x2 yb = *(const u32x2*)(p.YS + (size_t)row * 512 + c); const f32x4 a = acc[ai][bj][m][n];
                        f32x4 y; y[0] = __uint_as_float(yb.x << 16); y[1] = __uint_as_float(yb.x & 0xffff0000u); y[2] = __uint_as_float(yb.y << 16); y[3] = __uint_as_float(yb.y & 0xffff0000u);
                        f32x4 o;
#pragma unroll
                        for (int e = 0; e < 4; ++e) o[e] = y[e] * __builtin_amdgcn_rcpf(1.0f + __builtin_amdgcn_exp2f(-1.4426950408889634f * a[e]));
                        st_bf4(p.CAT + (size_t)row * 1024 + c, o); }
                asm volatile("" ::: "memory");
            }
    }
};
struct EpiOut {
    static constexpr bool PERM = false, AFTER_DRAIN = false;
    P p;
    __device__ __forceinline__ void operator()(const f32x4 (&acc)[2][2][4][2], const Unit& u, int wr, int wc, int fr, int fq) const {
        { const int t_ = fresh_tid(); fr = t_ & 15; fq = (t_ >> 4) & 3; }
#pragma unroll
        for (int ai = 0; ai < 2; ++ai)
#pragma unroll
            for (int m = 0; m < 4; ++m) {
                const int row = u.pm * 256 + ai * 128 + wr * 64 + m * 16 + fr; const float* xr = x0_row(p, row); float s = 0.f;
#pragma unroll
                for (int bj = 0; bj < 2; ++bj)
#pragma unroll
                    for (int n = 0; n < 2; ++n) { const int c = u.pn * 256 + bj * 128 + wc * 32 + n * 16 + 4 * fq;
                        const f32x4 v = *(const f32x4*)(xr + c) + acc[ai][bj][m][n]; s += sq4(v);
                        *(f32x4*)(p.X1 + (size_t)row * 1024 + c) = v; st_bf4(p.X1B + (size_t)row * 1024 + c, v); }
                s += __shfl_xor(s, 16); s += __shfl_xor(s, 32);
                if (fq == 0) p.SSQ1[(size_t)row * 16 + u.pn * 4 + wc] = s;
                asm volatile("" ::: "memory");
            }
    }
};
__device__ __forceinline__ float rstd_1(const P& p, int row) { const f32x4* q = (const f32x4*)(p.SSQ1 + (size_t)row * 16); const f32x4 a = q[0] + q[1] + q[2] + q[3];
    return 1.0f / sqrtf(((a[0] + a[1]) + (a[2] + a[3])) * (1.0f / 1024.0f) + EPS); }
struct EpiGU1 {
    static constexpr bool PERM = false, AFTER_DRAIN = false;
    P p;
    __device__ __forceinline__ void operator()(const f32x4 (&acc)[2][2][4][2], const Unit& u, int wr, int wc, int fr, int fq) const {
        { const int t_ = fresh_tid(); fr = t_ & 15; fq = (t_ >> 4) & 3; }
#pragma unroll
        for (int ai = 0; ai < 2; ++ai)
#pragma unroll
            for (int m = 0; m < 4; ++m) {
                const int row = u.pm * 256 + ai * 128 + wr * 64 + m * 16 + fr; const float rs = rstd_1(p, row);
#pragma unroll
                for (int n = 0; n < 2; ++n) { const int f = u.pn * 128 + wc * 32 + n * 16 + 4 * fq;
                    *(f32x4*)(p.GATE + (size_t)row * 2816 + f) = acc[ai][0][m][n] * rs; st_bf4(p.UPB + (size_t)row * 2816 + f, acc[ai][1][m][n] * rs); }
                asm volatile("" ::: "memory");
            }
    }
};
__device__ __forceinline__ void conv_pass(const P& p, int vcu, int G) {
    const int gid = vcu * NTHREADS + fresh_tid(), nth = G * NTHREADS;
    for (int i = gid; i < MP * 704; i += nth) { const int fr = i / 704, f = (i % 704) * 4;
        if (fr >= FR_META + 16 && fr < FR_SAMP) { *(u32x2*)(p.H + (size_t)fr * 2816 + f) = (u32x2){0u, 0u}; continue; }
        const f32x4 g2 = *(const f32x4*)(p.GATE + (size_t)fr * 2816 + f); f32x4 g1, g0; const f32x4 z = {0.f, 0.f, 0.f, 0.f};
        if (fr < FR_META) { const int tq = fr & 4095;
            g1 = *(const f32x4*)(p.GATE + (size_t)(tq >= 1 ? fr - 1 : FR_META + 15) * 2816 + f);
            g0 = *(const f32x4*)(p.GATE + (size_t)(tq >= 2 ? fr - 2 : FR_META + 14 + tq) * 2816 + f); }
        else if (fr < FR_SAMP) { const int t = fr - FR_META;
            g1 = t >= 1 ? *(const f32x4*)(p.GATE + (size_t)(fr - 1) * 2816 + f) : z; g0 = t >= 2 ? *(const f32x4*)(p.GATE + (size_t)(fr - 2) * 2816 + f) : z; }
        else { const int s = fr - FR_SAMP, db = s >> 3, ts = s & 7;
            g1 = ts >= 1 ? *(const f32x4*)(p.GATE + (size_t)(fr - 1) * 2816 + f) : *(const f32x4*)(p.st_conv + ((size_t)db * 2 + 1) * 2816 + f);
            g0 = ts >= 2 ? *(const f32x4*)(p.GATE + (size_t)(fr - 2) * 2816 + f) : *(const f32x4*)(p.st_conv + ((size_t)db * 2 + ts) * 2816 + f); }
        const f32x4 w0 = *(const f32x4*)(p.conv_w + f), w1 = *(const f32x4*)(p.conv_w + 2816 + f), w2 = *(const f32x4*)(p.conv_w + 5632 + f), cb = *(const f32x4*)(p.conv_b + f);
        const u32x2 ub = *(const u32x2*)(p.UPB + (size_t)fr * 2816 + f);
        f32x4 up; up[0] = __uint_as_float(ub.x << 16); up[1] = __uint_as_float(ub.x & 0xffff0000u); up[2] = __uint_as_float(ub.y << 16); up[3] = __uint_as_float(ub.y & 0xffff0000u);
        const f32x4 c = cb + w0 * g0 + w1 * g1 + w2 * g2; f32x4 h;
#pragma unroll
        for (int e = 0; e < 4; ++e) h[e] = c[e] * __builtin_amdgcn_rcpf(1.0f + __builtin_amdgcn_exp2f(-1.4426950408889634f * c[e])) * up[e];
        st_bf4(p.H + (size_t)fr * 2816 + f, h);
        if (fr < FR_META) { const int b = fr >> 12, tq = fr & 4095; if (tq >= 4094) *(f32x4*)(p.out + nv::O_CONVP + ((size_t)b * 2 + (tq - 4094)) * 2816 + f) = g2; }
        else if (fr >= FR_SAMP) { const int s = fr - FR_SAMP, db = s >> 3, ts = s & 7; if (ts >= 6) *(f32x4*)(p.out + nv::O_CONVS + ((size_t)db * 2 + (ts - 6)) * 2816 + f) = g2; }
    }
}
struct EpiDown1 {
    static constexpr bool PERM = false, AFTER_DRAIN = false;
    P p;
    __device__ __forceinline__ void operator()(const f32x4 (&acc)[2][2][4][2], const Unit& u, int wr, int wc, int fr, int fq) const {
        { const int t_ = fresh_tid(); fr = t_ & 15; fq = (t_ >> 4) & 3; }
#pragma unroll
        for (int ai = 0; ai < 2; ++ai)
#pragma unroll
            for (int m = 0; m < 4; ++m) {
                const int row = u.pm * 256 + ai * 128 + wr * 64 + m * 16 + fr;
#pragma unroll
                for (int bj = 0; bj < 2; ++bj)
#pragma unroll
                    for (int n = 0; n < 2; ++n) { const size_t o = (size_t)row * 1024 + u.pn * 256 + bj * 128 + wc * 32 + n * 16 + 4 * fq;
                        *(f32x4*)(p.X2 + o) = *(const f32x4*)(p.X1 + o) + acc[ai][bj][m][n]; }
                asm volatile("" ::: "memory");
            }
    }
};
__device__ __forceinline__ void final_pass(const P& p, int vcu, int G) {
    const int tid_ = fresh_tid(), lane = tid_ & 63, wave = tid_ >> 6; const int gw = vcu * NWAVES + wave, NGW = G * NWAVES;
    for (int fr = gw; fr < MP; fr += NGW) {
        float* dst;
        if (fr < FR_META) dst = p.out + nv::O_YP + (size_t)fr * 1024; else if (fr >= FR_SAMP) dst = p.out + nv::O_YS + (size_t)(fr - FR_SAMP) * 1024; else continue;
        const f32x4* xr = (const f32x4*)(p.X2 + (size_t)fr * 1024) + lane; const f32x4* gr = (const f32x4*)p.g_final + lane;
        f32x4 v[4]; float s = 0.f;
#pragma unroll
        for (int j = 0; j < 4; ++j) { v[j] = xr[64 * j]; s += sq4(v[j]); }
        const float rs = 1.0f / sqrtf(wsum(s) * (1.0f / 1024.0f) + EPS);
#pragma unroll
        for (int j = 0; j < 4; ++j) ((f32x4*)dst + lane)[64 * j] = v[j] * rs * gr[64 * j];
    }
}
}
namespace fk {
typedef short s16x4 __attribute__((ext_vector_type(4)));
typedef float f32x16 __attribute__((ext_vector_type(16)));
#define FK_SBAR() __builtin_amdgcn_sched_barrier(0)
constexpr int AT_KROW = 400;
constexpr int AT_KHALF = 64 * AT_KROW;
constexpr int AT_VOFF = 2 * AT_KHALF;
constexpr int AT_VHALF = 64 * 128 * 2;
constexpr int AT_WS = AT_VOFF + 2 * AT_VHALF;
constexpr int AT_LDS = AT_WS + 8 * 64 * 4;
__device__ __forceinline__ int v_st(int k, int c) { const int kk = (k & ~0xC) | ((k & 4) << 1) | ((k & 8) >> 1); return ((kk >> 3) * 4 + (c >> 5)) * 512 + ((kk & 7) * 32 + (c & 31)) * 2; }
__device__ __forceinline__ int v_rd_base(int lane) { return ((lane & 3) << 3) | (((lane >> 2) & 3) << 6) | (((lane >> 4) & 1) << 5) | (((lane >> 5) & 1) << 8); }
constexpr int v_rd_off(int d0, int ks, int half) { return d0 * 512 + ks * 4096 + half * 2048; }
__device__ __forceinline__ int crow(int r, int hi) { return (r & 3) + 8 * (r >> 2) + 4 * hi; }
__device__ __forceinline__ unsigned cvtpk(float lo, float hi) { unsigned r; asm volatile("v_cvt_pk_bf16_f32 %0, %1, %2" : "=v"(r) : "v"(lo), "v"(hi)); return r; }
__device__ __forceinline__ void mask_tile(f32x16& p0, f32x16& p1, int dq, unsigned W) {
    const float NEG = -__builtin_inff();
#pragma unroll
    for (int r = 0; r < 16; ++r) { const int c = (r & 3) + 8 * (r >> 2);
        if ((unsigned)(dq - c) >= W) p0[r] = NEG;
        if ((unsigned)(dq - c - 32) >= W) p1[r] = NEG; }
}
constexpr float AT_THR = 8.f;
__device__ __forceinline__ void partialSM(f32x16& p0, f32x16& p1, float& m_reg, float& alpha) {
    float pmax = p0[0];
#pragma unroll
    for (int r = 1; r < 16; ++r) pmax = fmaxf(pmax, p0[r]);
#pragma unroll
    for (int r = 0; r < 16; ++r) pmax = fmaxf(pmax, p1[r]);
    { auto rr = __builtin_amdgcn_permlane32_swap(__float_as_uint(pmax), __float_as_uint(pmax), false, false);
      pmax = fmaxf(__uint_as_float(rr[0]), __uint_as_float(rr[1])); }
    float mn;
    if (__builtin_expect(__all((pmax - m_reg) <= AT_THR), 1)) { mn = m_reg; alpha = 1.f; }
    else { mn = fmaxf(m_reg, pmax); alpha = __builtin_amdgcn_exp2f(m_reg - mn); m_reg = mn; }
#pragma unroll
    for (int r = 0; r < 16; ++r) { p0[r] = __builtin_amdgcn_exp2f(p0[r] - mn); p1[r] = p1[r] - mn; }
}
__device__ __forceinline__ void finishSM(f32x16& p0, f32x16& p1, float alpha, float& l_reg, bf16x8& pa0, bf16x8& pa1, bf16x8& pa2, bf16x8& pa3) {
#pragma unroll
    for (int r = 0; r < 16; ++r) p1[r] = __builtin_amdgcn_exp2f(p1[r]);
    float ps = 0;
#pragma unroll
    for (int r = 0; r < 16; ++r) ps += p0[r];
#pragma unroll
    for (int r = 0; r < 16; ++r) ps += p1[r];
    { auto rr = __builtin_amdgcn_permlane32_swap(__float_as_uint(ps), __float_as_uint(ps), false, false);
      ps = __uint_as_float(rr[0]) + __uint_as_float(rr[1]); }
    l_reg = l_reg * alpha + ps;
#define FK_PK4(P, B_, OUT) do { unsigned a0 = cvtpk(P[B_+0], P[B_+1]), a1 = cvtpk(P[B_+2], P[B_+3]);                          \
        unsigned b0 = cvtpk(P[B_+4], P[B_+5]), b1 = cvtpk(P[B_+6], P[B_+7]);                                             \
        auto r0 = __builtin_amdgcn_permlane32_swap(a0, b0, false, false); auto r1 = __builtin_amdgcn_permlane32_swap(a1, b1, false, false); \
        v4u w = {r0[0], r1[0], r0[1], r1[1]}; OUT = *reinterpret_cast<bf16x8*>(&w); } while (0)
    FK_PK4(p0, 0, pa0); FK_PK4(p0, 8, pa1); FK_PK4(p1, 0, pa2); FK_PK4(p1, 8, pa3);
#undef FK_PK4
}
__device__ __forceinline__ void pv_tile(f32x16* o, int vb0, bf16x8 pa0, bf16x8 pa1, bf16x8 pa2, bf16x8 pa3) {
#define FK_TRRD(dst, off) asm volatile("ds_read_b64_tr_b16 %0, %1 offset:%2" : "=&v"(dst) : "v"(vb0), "i"(off) : "memory")
#define FK_PV_D0(d0) do { s16x4 l0, l1, l2, l3, h0, h1, h2, h3; constexpr int b_ = v_rd_off(d0, 0, 0); \
        FK_TRRD(l0, b_); FK_TRRD(h0, b_ + 2048); FK_TRRD(l1, b_ + 4096); FK_TRRD(h1, b_ + 6144); FK_TRRD(l2, b_ + 8192); FK_TRRD(h2, b_ + 10240); FK_TRRD(l3, b_ + 12288); FK_TRRD(h3, b_ + 14336); \
        asm volatile("s_waitcnt lgkmcnt(0)" ::: "memory"); FK_SBAR(); \
        o[d0] = __builtin_amdgcn_mfma_f32_32x32x16_bf16(pa0, (bf16x8){l0[0], l0[1], l0[2], l0[3], h0[0], h0[1], h0[2], h0[3]}, o[d0], 0, 0, 0);   \
        o[d0] = __builtin_amdgcn_mfma_f32_32x32x16_bf16(pa1, (bf16x8){l1[0], l1[1], l1[2], l1[3], h1[0], h1[1], h1[2], h1[3]}, o[d0], 0, 0, 0);   \
        o[d0] = __builtin_amdgcn_mfma_f32_32x32x16_bf16(pa2, (bf16x8){l2[0], l2[1], l2[2], l2[3], h2[0], h2[1], h2[2], h2[3]}, o[d0], 0, 0, 0);   \
        o[d0] = __builtin_amdgcn_mfma_f32_32x32x16_bf16(pa3, (bf16x8){l3[0], l3[1], l3[2], l3[3], h3[0], h3[1], h3[2], h3[3]}, o[d0], 0, 0, 0); } while (0)
    FK_PV_D0(0); FK_PV_D0(1); FK_PV_D0(2); FK_PV_D0(3);
#undef FK_PV_D0
#undef FK_TRRD
}
__device__ __forceinline__ int kpos_row(int b, int kp) { return kp < 16 ? FR_META + kp : (kp < TPK ? b * 4096 + kp - 16 : b * 4096 + 4095); }

__device__ __forceinline__ void attn_prompt_unit(const P& p, LAS unsigned char* lds, int b, int h, int j2) {
    const int tid = fresh_tid(), lane = tid & 63, wid = __builtin_amdgcn_readfirstlane(tid >> 6), r32 = lane & 31, hi = lane >> 5;
    const int wq = wid & 3, kh = wid >> 2;
    const int tq0 = 128 * j2 + 32 * wq, pq0 = 16 + tq0;
    LAS unsigned char* K_lds = lds; LAS unsigned char* V_lds = lds + AT_VOFF;
    LAS float* wsf = (LAS float*)(lds + AT_WS) + wid * 64; LAS float* li_l = wsf; LAS float* al_l = wsf + 32;
    bf16x8 qr[12];
    { const bf16_t* qp = p.QB + ((size_t)(b * 4096 + tq0 + r32) * 4 + h) * 192 + hi * 8;
#pragma unroll
      for (int d0 = 0; d0 < 12; ++d0) qr[d0] = *(const bf16x8*)(qp + d0 * 16); }
    float m_reg = -1e30f, l_reg = 0.f; f32x16 o[4] = {};
    const int NDT = j2 + 2;
    v4u sk[6], sv[4];
#define FK_STAGE_LOAD(dt) do { const int kp0_ = 128 * (dt); int tl_ = tid; asm volatile("" : "+v"(tl_));   \
        _Pragma("unroll") for (int i_ = 0; i_ < 6; ++i_) { const int ci = tl_ + 512 * i_, key = ci / 24, ch = ci - key * 24; \
            sk[i_] = *(const v4u*)(p.KB + ((size_t)kpos_row(b, kp0_ + key) * 4 + h) * 192 + ch * 8); } \
        _Pragma("unroll") for (int i_ = 0; i_ < 4; ++i_) { const int ci = tl_ + 512 * i_, key = ci >> 4, ch = ci & 15; \
            sv[i_] = *(const v4u*)(p.VB + ((size_t)kpos_row(b, kp0_ + key) * 4 + h) * 128 + ch * 8); } } while (0)
#define FK_STAGE_WRITE() do { int tl_ = tid; asm volatile("" : "+v"(tl_)); \
        _Pragma("unroll") for (int i_ = 0; i_ < 6; ++i_) { const int ci = tl_ + 512 * i_, key = ci / 24, ch = ci - key * 24; \
            *(LAS v4u*)(K_lds + (key >> 6) * AT_KHALF + (key & 63) * AT_KROW + ch * 16) = sk[i_]; } \
        _Pragma("unroll") for (int i_ = 0; i_ < 4; ++i_) { const int ci = tl_ + 512 * i_, key = ci >> 4, ch = ci & 15; \
            *(LAS v4u*)(V_lds + (key >> 6) * AT_VHALF + v_st(key & 63, ch * 8)) = sv[i_]; } } while (0)
    FK_STAGE_LOAD(0);
    const int vb0 = (int)(unsigned)(size_t)(V_lds + kh * AT_VHALF) + v_rd_base(lane);
    const LAS unsigned char* kbp = K_lds + kh * AT_KHALF + r32 * AT_KROW + hi * 16;
    for (int dt = 0; dt < NDT; ++dt) {
        __syncthreads();
        FK_STAGE_WRITE();
        if (dt + 1 < NDT) FK_STAGE_LOAD(dt + 1);
        __syncthreads();
        const int kb = 128 * dt + 64 * kh;
        f32x16 p0 = {}, p1 = {};
#pragma unroll
        for (int d0 = 0; d0 < 12; ++d0) {
            const bf16x8 b0 = *(const LAS bf16x8*)(kbp + 32 * d0), b1 = *(const LAS bf16x8*)(kbp + 32 * AT_KROW + 32 * d0);
            p0 = __builtin_amdgcn_mfma_f32_32x32x16_bf16(b0, qr[d0], p0, 0, 0, 0);
            p1 = __builtin_amdgcn_mfma_f32_32x32x16_bf16(b1, qr[d0], p1, 0, 0, 0); }
        if (kb + 63 > pq0) mask_tile(p0, p1, pq0 + r32 - kb - 4 * hi, 0x7fffffffu);
        float alpha; bf16x8 pa0, pa1, pa2, pa3;
        partialSM(p0, p1, m_reg, alpha);
        finishSM(p0, p1, alpha, l_reg, pa0, pa1, pa2, pa3);
        if (__any(alpha < 1.f)) { if (hi == 0) al_l[r32] = alpha; asm volatile("s_waitcnt lgkmcnt(0)" ::: "memory");
#pragma unroll
            for (int d_ = 0; d_ < 4; ++d_)
#pragma unroll
                for (int r = 0; r < 16; ++r) o[d_][r] *= al_l[crow(r, hi)]; }
        FK_SBAR();
        pv_tile(o, vb0, pa0, pa1, pa2, pa3);
    }
#undef FK_STAGE_LOAD
#undef FK_STAGE_WRITE
    __syncthreads();
    LAS float* mb = (LAS float*)lds;
    LAS float* ob = (LAS float*)(lds + 1024);
    if (kh == 1) { if (hi == 0) { mb[wq * 64 + r32] = m_reg; mb[wq * 64 + 32 + r32] = l_reg; }
#pragma unroll
        for (int d_ = 0; d_ < 4; ++d_)
#pragma unroll
            for (int r = 0; r < 16; ++r) ob[(wq * 64 + d_ * 16 + r) * 64 + lane] = o[d_][r]; }
    __syncthreads();
    if (kh == 0) {
        const float m2 = mb[wq * 64 + r32], l2 = mb[wq * 64 + 32 + r32];
        const float M = fmaxf(m_reg, m2), f1 = __builtin_amdgcn_exp2f(m_reg - M), f2 = __builtin_amdgcn_exp2f(m2 - M);
        const float l = l_reg * f1 + l2 * f2, rl = __builtin_amdgcn_rcpf(l);
        if (hi == 0) { li_l[r32] = f1 * rl; al_l[r32] = f2 * rl; }
        asm volatile("s_waitcnt lgkmcnt(0)" ::: "memory");
        bf16_t* Ow = p.CAT + (size_t)(b * 4096 + tq0) * 1024 + 512 + h * 128;
#pragma unroll
        for (int r = 0; r < 16; ++r) { const int orow = crow(r, hi); const float g1 = li_l[orow], g2 = al_l[orow];
#pragma unroll
            for (int d0 = 0; d0 < 4; ++d0) { const float v = o[d0][r] * g1 + ob[(wq * 64 + d0 * 16 + r) * 64 + lane] * g2;
                const float vn = __shfl_xor(v, 1);
                if ((r32 & 1) == 0) *(unsigned*)(Ow + (size_t)orow * 1024 + d0 * 32 + r32) = cvtpk(v, vn); } }
    }
    __syncthreads();
}
__device__ __forceinline__ void attn_meta(const P& p, LAS unsigned char* lds) {
    const int tid = fresh_tid(); LAS float* sc = (LAS float*)lds;
#pragma unroll 1
    for (int idx = tid; idx < 1024; idx += NTHREADS) { const int t = idx >> 6, h = (idx >> 4) & 3, k = idx & 15; float s = -__builtin_inff();
        if (k <= t) { s = 0.f; const bf16_t* q = p.QB + ((size_t)(FR_META + t) * 4 + h) * 192; const bf16_t* kk = p.KB + ((size_t)(FR_META + k) * 4 + h) * 192;
            for (int d = 0; d < 192; ++d) s += bf2f(q[d]) * bf2f(kk[d]); }
        sc[idx] = s; }
    __syncthreads();
#pragma unroll 1
    for (int it = tid; it < 2048; it += NTHREADS) { const int t = it >> 7, h = (it >> 5) & 3, v = (it & 31) * 4; const LAS float* s = sc + (t * 4 + h) * 16;
        float mx = s[0]; for (int k = 1; k <= t; ++k) mx = fmaxf(mx, s[k]);
        float l = 0.f; f32x4 acc = {0.f, 0.f, 0.f, 0.f};
        for (int k = 0; k <= t; ++k) { const float pk = __builtin_amdgcn_exp2f(s[k] - mx); l += pk; const bf16_t* vv = p.VB + ((size_t)(FR_META + k) * 4 + h) * 128 + v;
            acc[0] += pk * bf2f(vv[0]); acc[1] += pk * bf2f(vv[1]); acc[2] += pk * bf2f(vv[2]); acc[3] += pk * bf2f(vv[3]); }
        st_bf4(p.CAT + (size_t)(FR_META + t) * 1024 + 512 + h * 128 + v, acc * (1.0f / l)); }
    __syncthreads();
}
__device__ __forceinline__ void attn_prompt_phase(const P& p, LAS unsigned char* lds, int vcu, int G) {
    if (vcu == 0) attn_meta(p, lds);
    for (int item = vcu; item < 256; item += G) { const int bh = item >> 4, s = item & 15;
        attn_prompt_unit(p, lds, bh >> 2, bh & 3, 31 - s);
        attn_prompt_unit(p, lds, bh >> 2, bh & 3, s); }
}
}
namespace fk {
constexpr int SA_PITCH = 656;
constexpr int SA_Q = 0, SA_K = 32 * SA_PITCH, SA_V = SA_K + 64 * SA_PITCH, SA_WS = SA_V + 32768, SA_LDS = SA_WS + 2048;
constexpr int AP_STRIDE = 32 * 256 + 64;
__device__ __forceinline__ bf16x8 pack8f(f32x4 a, f32x4 b) { v4u w = {pk2(a[0], a[1]), pk2(a[2], a[3]), pk2(b[0], b[1]), pk2(b[2], b[3])}; return *reinterpret_cast<bf16x8*>(&w); }

__device__ __forceinline__ void attn_sample_unit(const P& p, LAS unsigned char* lds, int db, int half, int item) {
    const int tid = fresh_tid(), lane = tid & 63, wid = __builtin_amdgcn_readfirstlane(tid >> 6), r32 = lane & 31, hi = lane >> 5;
    const int quad = wid >> 2, cg = wid & 3;
    LAS unsigned char* Qs = lds + SA_Q; LAS unsigned char* Ks = lds + SA_K; LAS unsigned char* Vs = lds + SA_V;
    LAS float* wsf = (LAS float*)(lds + SA_WS) + wid * 64; LAS float* al_l = wsf + 32;
    { LAS float* qn = (LAS float*)Ks;
      for (int e = tid; e < 32 * 128; e += NTHREADS) { const int m = e >> 7, n = e & 127; qn[e] = bf2f(p.QB[((size_t)(FR_SAMP + db * 8 + (m >> 2)) * 4 + (m & 3)) * 192 + n]); }
      for (int e = tid; e < 32 * 64; e += NTHREADS) { const int m = e >> 6, i = e & 63;
          *(LAS bf16_t*)(Qs + m * SA_PITCH + (256 + i) * 2) = p.QB[((size_t)(FR_SAMP + db * 8 + (m >> 2)) * 4 + (m & 3)) * 192 + 128 + i]; }
      __syncthreads();
      const int r = tid & 255, hp = tid >> 8;
#pragma unroll 1
      for (int hh = 0; hh < 2; ++hh) { const int h = 2 * hp + hh; const f32x4* wr = (const f32x4*)(p.w_uk + (size_t)r * 512 + h * 128);
          float a[8];
#pragma unroll
          for (int qi = 0; qi < 8; ++qi) a[qi] = 0.f;
#pragma unroll 4
          for (int n4 = 0; n4 < 32; ++n4) { const f32x4 w = wr[n4];
#pragma unroll
              for (int qi = 0; qi < 8; ++qi) { const f32x4 q = *(const LAS f32x4*)(qn + (qi * 4 + h) * 128 + n4 * 4); a[qi] += (q[0] * w[0] + q[1] * w[1]) + (q[2] * w[2] + q[3] * w[3]); } }
#pragma unroll
          for (int qi = 0; qi < 8; ++qi) *(LAS bf16_t*)(Qs + (qi * 4 + h) * SA_PITCH + r * 2) = (bf16_t)(pk2(a[qi], a[qi]) & 0xffffu); }
      __syncthreads(); }
    const int NT = half ? 65 : 64;
    float m_reg = -1e30f, l_reg = 0.f; f32x16 o[2] = {};
    f32x4 sg[10];
#define FK_SLOAD(t) do { int tl_ = tid; asm volatile("" : "+v"(tl_)); const int key = tl_ >> 3, c8 = tl_ & 7; const float* cr; const float* kr; \
        if ((t) < 64) { const int j0 = half * 4096 + (t) * 64; const int pg = __builtin_amdgcn_readfirstlane(p.page_table[db * 64 + (j0 >> 7)]); const size_t rr = (size_t)pg * 128 + (j0 & 127) + key; \
            cr = p.cache_ckv + rr * 256; kr = p.cache_kr + rr * 64; } \
        else { const size_t rr = (size_t)db * 8 + (key & 7); cr = p.out + nv::O_CKVS + rr * 256; kr = p.out + nv::O_KRS + rr * 64; } \
        _Pragma("unroll") for (int i_ = 0; i_ < 4; ++i_) { sg[2 * i_] = *(const f32x4*)(cr + 8 * c8 + 64 * i_); sg[2 * i_ + 1] = *(const f32x4*)(cr + 8 * c8 + 64 * i_ + 4); } \
        sg[8] = *(const f32x4*)(kr + 8 * c8); sg[9] = *(const f32x4*)(kr + 8 * c8 + 4); } while (0)
#define FK_SWRITE() do { int tl_ = tid; asm volatile("" : "+v"(tl_)); const int key = tl_ >> 3, c8 = tl_ & 7; \
        _Pragma("unroll") for (int i_ = 0; i_ < 4; ++i_) { const bf16x8 v = pack8f(sg[2 * i_], sg[2 * i_ + 1]); const int col = 8 * c8 + 64 * i_; \
            *(LAS bf16x8*)(Ks + key * SA_PITCH + col * 2) = v; *(LAS bf16x8*)(Vs + (col >> 7) * 16384 + v_st(key, col & 127)) = v; } \
        *(LAS bf16x8*)(Ks + key * SA_PITCH + (256 + 8 * c8) * 2) = pack8f(sg[8], sg[9]); } while (0)
    FK_SLOAD(0);
    const LAS unsigned char* kbp = Ks + (32 * quad + r32) * SA_PITCH + hi * 16;
    const LAS unsigned char* qbp = Qs + r32 * SA_PITCH + hi * 16;
    const int vb0 = (int)(unsigned)(size_t)(Vs + (cg >> 1) * 16384) + v_rd_base(lane) + (2 * (cg & 1)) * 512 + (2 * quad) * 4096;
    for (int t = 0; t < NT; ++t) {
        __syncthreads();
        FK_SWRITE();
        if (t + 1 < NT) FK_SLOAD(t + 1);
        __syncthreads();
        f32x16 p0 = {};
#pragma unroll
        for (int d0 = 0; d0 < 20; ++d0) { const bf16x8 kf = *(const LAS bf16x8*)(kbp + 32 * d0), qf = *(const LAS bf16x8*)(qbp + 32 * d0);
            p0 = __builtin_amdgcn_mfma_f32_32x32x16_bf16(kf, qf, p0, 0, 0, 0); }
        if (t == 64) {
            const float NEG = -__builtin_inff();
#pragma unroll
            for (int r = 0; r < 16; ++r) { const int kk = 32 * quad + crow(r, hi); if (!(kk < 8 && kk <= (r32 >> 2))) p0[r] = NEG; } }
        float pmax = p0[0];
#pragma unroll
        for (int r = 1; r < 16; ++r) pmax = fmaxf(pmax, p0[r]);
        { auto rr = __builtin_amdgcn_permlane32_swap(__float_as_uint(pmax), __float_as_uint(pmax), false, false); pmax = fmaxf(__uint_as_float(rr[0]), __uint_as_float(rr[1])); }
        float mn, alpha;
        if (__builtin_expect(__all((pmax - m_reg) <= AT_THR), 1)) { mn = m_reg; alpha = 1.f; }
        else { mn = fmaxf(m_reg, pmax); alpha = __builtin_amdgcn_exp2f(m_reg - mn); m_reg = mn; }
        float ps = 0.f;
#pragma unroll
        for (int r = 0; r < 16; ++r) { p0[r] = __builtin_amdgcn_exp2f(p0[r] - mn); ps += p0[r]; }
        { auto rr = __builtin_amdgcn_permlane32_swap(__float_as_uint(ps), __float_as_uint(ps), false, false); ps = __uint_as_float(rr[0]) + __uint_as_float(rr[1]); }
        l_reg = l_reg * alpha + ps;
        bf16x8 pa0, pa1;
#define FK_PK4(P, B_, OUT) do { unsigned a0 = cvtpk(P[B_+0], P[B_+1]), a1 = cvtpk(P[B_+2], P[B_+3]); unsigned b0 = cvtpk(P[B_+4], P[B_+5]), b1 = cvtpk(P[B_+6], P[B_+7]); \
        auto r0 = __builtin_amdgcn_permlane32_swap(a0, b0, false, false); auto r1 = __builtin_amdgcn_permlane32_swap(a1, b1, false, false); \
        v4u w = {r0[0], r1[0], r0[1], r1[1]}; OUT = *reinterpret_cast<bf16x8*>(&w); } while (0)
        FK_PK4(p0, 0, pa0); FK_PK4(p0, 8, pa1);
#undef FK_PK4
        if (__any(alpha < 1.f)) { if (hi == 0) al_l[r32] = alpha; asm volatile("s_waitcnt lgkmcnt(0)" ::: "memory");
#pragma unroll
            for (int d_ = 0; d_ < 2; ++d_)
#pragma unroll
                for (int r = 0; r < 16; ++r) o[d_][r] *= al_l[crow(r, hi)]; }
        FK_SBAR();
#define FK_TRRD(dst, off) asm volatile("ds_read_b64_tr_b16 %0, %1 offset:%2" : "=&v"(dst) : "v"(vb0), "i"(off) : "memory")
#define FK_PV2(d) do { s16x4 l0, l1, h0, h1; FK_TRRD(l0, (d) * 512); FK_TRRD(h0, (d) * 512 + 2048); FK_TRRD(l1, (d) * 512 + 4096); FK_TRRD(h1, (d) * 512 + 6144); \
        asm volatile("s_waitcnt lgkmcnt(0)" ::: "memory"); FK_SBAR(); \
        o[d] = __builtin_amdgcn_mfma_f32_32x32x16_bf16(pa0, (bf16x8){l0[0], l0[1], l0[2], l0[3], h0[0], h0[1], h0[2], h0[3]}, o[d], 0, 0, 0); \
        o[d] = __builtin_amdgcn_mfma_f32_32x32x16_bf16(pa1, (bf16x8){l1[0], l1[1], l1[2], l1[3], h1[0], h1[1], h1[2], h1[3]}, o[d], 0, 0, 0); } while (0)
        FK_PV2(0); FK_PV2(1);
#undef FK_PV2
#undef FK_TRRD
    }
#undef FK_SLOAD
#undef FK_SWRITE
    __syncthreads();
    LAS float* mb = (LAS float*)(lds + SA_K);
    LAS float* ob = (LAS float*)(lds + SA_K + 1024);
    if (quad == 1) { if (hi == 0) { mb[cg * 64 + r32] = m_reg; mb[cg * 64 + 32 + r32] = l_reg; }
#pragma unroll
        for (int d_ = 0; d_ < 2; ++d_)
#pragma unroll
            for (int r = 0; r < 16; ++r) ob[(cg * 32 + d_ * 16 + r) * 64 + lane] = o[d_][r]; }
    __syncthreads();
    if (quad == 0) {
        const float m2 = mb[cg * 64 + r32], l2 = mb[cg * 64 + 32 + r32];
        const float M = fmaxf(m_reg, m2), f1 = __builtin_amdgcn_exp2f(m_reg - M), f2 = __builtin_amdgcn_exp2f(m2 - M);
        const float l = l_reg * f1 + l2 * f2;
        if (hi == 0) { wsf[r32] = f1; al_l[r32] = f2; }
        asm volatile("s_waitcnt lgkmcnt(0)" ::: "memory");
        float* ap = p.APART + (size_t)item * AP_STRIDE;
        if (cg == 0 && hi == 0) { ap[32 * 256 + r32] = M; ap[32 * 256 + 32 + r32] = l; }
#pragma unroll
        for (int r = 0; r < 16; ++r) { const int orow = crow(r, hi); const float g1 = wsf[orow], g2 = al_l[orow];
#pragma unroll
            for (int d_ = 0; d_ < 2; ++d_) ap[orow * 256 + 64 * cg + 32 * d_ + r32] = o[d_][r] * g1 + ob[(cg * 32 + d_ * 16 + r) * 64 + lane] * g2; }
    }
    __syncthreads();
}
__device__ __forceinline__ void attn_sample_phase(const P& p, LAS unsigned char* lds, int vcu, int G) {
    for (int item = vcu; item < 256; item += G) attn_sample_unit(p, lds, item >> 1, item & 1, item);
}
__device__ __forceinline__ void attn_sample_combine(const P& p, LAS unsigned char* lds, int vcu, int G) {
    const int tid = fresh_tid(); LAS float* ol = (LAS float*)lds;
    for (int db = vcu; db < 128; db += G) {
        const float* a0 = p.APART + (size_t)(2 * db) * AP_STRIDE; const float* a1 = a0 + AP_STRIDE;
        __syncthreads();
        for (int e = tid; e < 32 * 256; e += NTHREADS) { const int m = e >> 8;
            const float m0 = a0[8192 + m], m1 = a1[8192 + m], l0 = a0[8192 + 32 + m], l1 = a1[8192 + 32 + m];
            const float M = fmaxf(m0, m1), f0 = __builtin_amdgcn_exp2f(m0 - M), f1 = __builtin_amdgcn_exp2f(m1 - M);
            ol[e] = (a0[e] * f0 + a1[e] * f1) / (l0 * f0 + l1 * f1); }
        __syncthreads();
        const int h = tid >> 7, v = tid & 127; float acc[8];
#pragma unroll
        for (int qi = 0; qi < 8; ++qi) acc[qi] = 0.f;
#pragma unroll 4
        for (int r = 0; r < 256; ++r) { const float w = p.w_uv[(size_t)r * 512 + h * 128 + v];
#pragma unroll
            for (int qi = 0; qi < 8; ++qi) acc[qi] += ol[(qi * 4 + h) * 256 + r] * w; }
#pragma unroll
        for (int qi = 0; qi < 8; ++qi) p.CAT[(size_t)(FR_SAMP + db * 8 + qi) * 1024 + 512 + h * 128 + v] = (bf16_t)(pk2(acc[qi], acc[qi]) & 0xffffu);
    }
    __syncthreads();
}
}
namespace fk {
__device__ __forceinline__ float gelu_tanh(float x) { const float u = 0.7978845608028654f * (x + 0.044715f * x * x * x); const float e = __builtin_amdgcn_exp2f(2.885390081777927f * u);
    return 0.5f * x * (2.0f - 2.0f * __builtin_amdgcn_rcpf(e + 1.0f)); }
__device__ __forceinline__ void s5_slow_item(const P& p, LAS float* part  , int seq, int g) {
    const int lane = fresh_tid() & 63, pp = lane; const bool prompt = seq < 4; const int db = seq - 4;
    const int gp = g * 64 + pp;
    const float ar = p.abar_re[gp], ai = p.abar_im[gp];
    float br[16], bi[16], cr[16], ci[16];
#pragma unroll
    for (int j = 0; j < 16; ++j) { br[j] = p.bbar_re[gp * 16 + j]; bi[j] = p.bbar_im[gp * 16 + j]; cr[j] = p.c_re[(g * 16 + j) * 64 + pp]; ci[j] = p.c_im[(g * 16 + j) * 64 + pp]; }
    float hr = prompt ? 0.f : p.st_re[(size_t)db * 2048 + gp], hi_ = prompt ? 0.f : p.st_im[(size_t)db * 2048 + gp];
    const float dk = p.s5_d[g * 16 + (lane & 15)];
    const int T = prompt ? TPK : 8;
#pragma unroll 1
    for (int t = 0; t < T; ++t) {
        const int fr = prompt ? (t < 16 ? FR_META + t : seq * 4096 + t - 16) : FR_SAMP + db * 8 + t;
        const v4u u0 = *(const v4u*)(p.U + (size_t)fr * 512 + g * 16), u1 = *(const v4u*)(p.U + (size_t)fr * 512 + g * 16 + 8);
        float u[16];
#pragma unroll
        for (int k = 0; k < 4; ++k) { u[2 * k] = __uint_as_float(u0[k] << 16); u[2 * k + 1] = __uint_as_float(u0[k] & 0xffff0000u); u[8 + 2 * k] = __uint_as_float(u1[k] << 16); u[8 + 2 * k + 1] = __uint_as_float(u1[k] & 0xffff0000u); }
        float bur = 0.f, bui = 0.f;
#pragma unroll
        for (int j = 0; j < 16; ++j) { bur += br[j] * u[j]; bui += bi[j] * u[j]; }
        const float nr = ar * hr - ai * hi_ + bur, ni = ar * hi_ + ai * hr + bui; hr = nr; hi_ = ni;
#pragma unroll
        for (int j = 0; j < 16; ++j) part[pp * 17 + j] = cr[j] * hr - ci[j] * hi_;
        asm volatile("s_waitcnt lgkmcnt(0)" ::: "memory");
        float s = 0.f; const int j = lane & 15, q4 = lane >> 4;
#pragma unroll
        for (int k = 0; k < 16; ++k) s += part[(q4 * 16 + k) * 17 + j];
        s += __shfl_xor(s, 16); s += __shfl_xor(s, 32);
        float uj = u[0];
#pragma unroll
        for (int k = 1; k < 16; ++k) uj = (j == k) ? u[k] : uj;
        const float y = gelu_tanh(s + dk * uj);
        if (lane < 16) p.YS[(size_t)fr * 512 + g * 16 + j] = (bf16_t)(pk2(y, y) & 0xffffu);
        asm volatile("s_waitcnt lgkmcnt(0)" ::: "memory");
    }
    if (prompt) { p.out[nv::O_SREP + (size_t)seq * 2048 + gp] = hr; p.out[nv::O_SIMP + (size_t)seq * 2048 + gp] = hi_; }
    else { p.out[nv::O_SRES + (size_t)db * 2048 + gp] = hr; p.out[nv::O_SIMS + (size_t)db * 2048 + gp] = hi_; }
}
__device__ __forceinline__ void s5_slow_phase(const P& p, LAS unsigned char* lds, int vcu, int G) {
    const int wave = fresh_tid() >> 6; LAS float* part = (LAS float*)lds + wave * (64 * 17);
    for (int it = vcu + G * wave; it < 132 * 32; it += G * NWAVES) s5_slow_item(p, part, it >> 5, it & 31);
    const int gid = vcu * NTHREADS + fresh_tid(), nth = G * NTHREADS;
    for (int i = gid; i < 240 * 64; i += nth) *(v4u*)(p.YS + (size_t)(FR_META + 16) * 512 + (size_t)i * 8) = (v4u){0u, 0u, 0u, 0u};
}
}
namespace fk {
constexpr int LDS_BYTES = 147456, LDSCTL_OFF = 131072, MISC_OFF = LDSCTL_OFF + 320;
constexpr int CW_BAR = 4096;
extern __shared__ __attribute__((aligned(16))) unsigned char lds_dyn[];
#define FK_GEMM(EPI, A_, B_, M_, N_, K_) do { int k_ = (K_); asm volatile("" : "+s"(k_));     \
        pg8::Gemm g_{A_, B_, M_, N_, k_}; pg8::StaticOrder S_; S_.init(M_, N_, G, (int)blockIdx.x); EPI E_{p}; \
        pg8::gemm_phase<EPI, pg8::StaticOrder, true, true>(lds, g_, S_, E_); } while (0)
__global__ void __launch_bounds__(512, 2) mk_fwd(P p) {
    LAS unsigned char* lds = (LAS unsigned char*)lds_dyn;
    const int tid = threadIdx.x, G = gridDim.x; const int bx = blockIdx.x; const int vcu = (G % 8 == 0) ? (bx % 8) * (G / 8) + bx / 8 : bx;
    for (int u = tid; u < (LDS_BYTES - LDSCTL_OFF) / 4; u += NTHREADS) ((LAS unsigned*)(lds + LDSCTL_OFF))[u] = 0u;
    __syncthreads();
    XcdBarrier bar = xcd_barrier_post((unsigned*)p.ctl + CW_BAR, (volatile LAS unsigned*)(lds + MISC_OFF) + 8);
    prologue(p, lds, vcu, G);
    xcd_barrier(bar);
    FK_GEMM(EpiIn, p.XN, p.Bt_in, MP, 1280, 1024);
    xcd_barrier(bar);
    FK_GEMM(EpiQ, p.CQ, p.Bt_uq, MP, 768, 384);
    FK_GEMM(EpiKV, p.CKVB, p.Bt_kv, 65 * 256, 1024, 256);
    ckv_fixup(p, vcu, G);
    __syncthreads();
    s5_slow_phase(p, lds, vcu, G);
    xcd_barrier(bar);
    attn_prompt_phase(p, lds, vcu, G);
    attn_sample_phase(p, lds, vcu, G);
    xcd_barrier(bar);
    attn_sample_combine(p, lds, vcu, G);
    FK_GEMM(EpiGLU, p.YS, p.Bt_glu, MP, 512, 512);
    xcd_barrier(bar);
    FK_GEMM(EpiOut, p.CAT, p.Bt_out, MP, 1024, 1024);
    xcd_barrier(bar);
    FK_GEMM(EpiGU1, p.X1B, p.Bt_gu, MP, 5632, 1024);
    xcd_barrier(bar);
    conv_pass(p, vcu, G);
    xcd_barrier(bar);
    FK_GEMM(EpiDown1, p.H, p.Bt_down, MP, 1024, 2816);
    xcd_barrier(bar);
    final_pass(p, vcu, G);
}
inline void launch(void* const* d_in, float* out, void* d_ws, hipStream_t stream) {
    static int grid = 0;
    if (grid == 0) {
        int dev = 0, cus = 0;
        if (hipGetDevice(&dev) != hipSuccess || hipDeviceGetAttribute(&cus, hipDeviceAttributeMultiprocessorCount, dev) != hipSuccess) { grid = -1; return; }
        if (hipFuncSetAttribute((const void*)mk_fwd, hipFuncAttributeMaxDynamicSharedMemorySize, LDS_BYTES) != hipSuccess) { grid = -1; return; }
        grid = cus;
    }
    if (grid < 0) return;
    P p{}; fill_inputs(p, d_in, out); carve(p, (char*)d_ws);
    (void)hipMemsetAsync(p.ctl, 0, (size_t)1 << 20, stream);
    hipLaunchKernelGGL(mk_fwd, dim3(grid), dim3(NTHREADS), LDS_BYTES, stream, p);
}
}
extern "C" void kernel_launch(void* const* d_in, const int* in_sizes, int n_in,
                              void* d_out, int out_size, void* d_ws, size_t ws_size,
                              hipStream_t stream) {
    fk::launch(d_in, (float*)d_out, d_ws, stream);
}
```

```cpp
#include <hip/hip_runtime.h>
#include <math.h>
namespace nv {
constexpr int D_MODEL = 1024, BATCH = 4, SEQ = 4096, DEC_BATCH = 128, DEC_SEQ = 8, PAST_LEN = 8192, PAGE_SIZE = 128;
constexpr int N_META = 16, S5_W = 512, S5_GROUP = 16, S5_GROUPS = 32, S5_STATE = 64, MLA_HEADS = 4, QK_NOPE = 128, QK_ROPE = 64, V_HEAD = 128;
constexpr int Q_RANK = 384, KV_RANK = 256, D_FF = 2816, IN_W = 1216, N_PAGES = 64, N_POOL = 10240;
constexpr int TP = N_META + SEQ;
constexpr int RP = BATCH * TP;
constexpr int RS = DEC_BATCH * DEC_SEQ;
constexpr int R = RP + RS;
constexpr float EPS = 1e-6f;
constexpr float ATTN_SCALE = 0.07216878364870322f;
constexpr size_t O_YP = 0, O_YS = O_YP + (size_t)BATCH * SEQ * D_MODEL, O_CKVP = O_YS + (size_t)RS * D_MODEL, O_KRP = O_CKVP + (size_t)RP * KV_RANK,
                 O_SREP = O_KRP + (size_t)RP * QK_ROPE, O_SIMP = O_SREP + BATCH * S5_GROUPS * S5_STATE, O_CONVP = O_SIMP + BATCH * S5_GROUPS * S5_STATE,
                 O_CKVS = O_CONVP + BATCH * 2 * D_FF, O_KRS = O_CKVS + (size_t)RS * KV_RANK, O_SRES = O_KRS + (size_t)RS * QK_ROPE,
                 O_SIMS = O_SRES + DEC_BATCH * S5_GROUPS * S5_STATE, O_CONVS = O_SIMS + DEC_BATCH * S5_GROUPS * S5_STATE, O_END = O_CONVS + (size_t)DEC_BATCH * 2 * D_FF;

}
#define GAS __attribute__((address_space(1)))
#define LAS __attribute__((address_space(3)))
typedef unsigned short bf16;
typedef unsigned v4u __attribute__((ext_vector_type(4)));
typedef float f32x4 __attribute__((ext_vector_type(4)));
typedef short bf16x8 __attribute__((ext_vector_type(8)));
typedef GAS unsigned gu32;
typedef GAS unsigned long long gu64;
#define RLX_AGENT __ATOMIC_RELAXED, __HIP_MEMORY_SCOPE_AGENT
#define LDS_WAIT() asm volatile("s_waitcnt lgkmcnt(0)" ::: "memory")
#define VM_WAIT() asm volatile("s_waitcnt vmcnt(0)" ::: "memory")
__device__ __forceinline__ unsigned long long rt() { return __builtin_amdgcn_s_memrealtime(); }
__device__ __forceinline__ unsigned f2bf(float f) { unsigned u = __builtin_bit_cast(unsigned, f); return (u + 0x7fffu + ((u >> 16) & 1u)) >> 16; }
__device__ __forceinline__ unsigned pk2(float lo, float hi) { return f2bf(lo) | (f2bf(hi) << 16); }

#define XB_TMO      128
#define XB_XCNT(j)  (256  + 64 * (j))
#define XB_XSUB(j)  (1280 + 64 * (j))
#define XB_XGEN(j)  (2304 + 64 * (j))
#define XB_TOP      3328
#define XB_TOPGEN   3392
#define XCD_BAR_WORDS 3456
#define XB_SPIN_CAP (1u << 18)

__device__ __forceinline__ unsigned xb_ld(unsigned* p)              { return __hip_atomic_load(p, __ATOMIC_RELAXED, __HIP_MEMORY_SCOPE_AGENT); }
__device__ __forceinline__ unsigned xb_add(unsigned* p, unsigned v) { return __hip_atomic_fetch_add(p, v, __ATOMIC_RELAXED, __HIP_MEMORY_SCOPE_AGENT); }
__device__ __forceinline__ unsigned xb_xcc_id() { return (unsigned)__builtin_amdgcn_s_getreg((3 << 11) | 20) & 0xFu; }
#define XB_SPIN(cond, bar) do { unsigned _sp = 0; while (cond) { __builtin_amdgcn_s_sleep(1); \
    if ((++_sp & 255u) == 0u) { if (xb_ld(&(bar)[XB_TMO])) break; if (_sp > XB_SPIN_CAP) { atomicAdd(&(bar)[XB_TMO], 1u); break; } } } } while (0)

struct XcdBarrier {
    unsigned* bar; unsigned x;
    volatile LAS unsigned* st;
};

__device__ __forceinline__ XcdBarrier xcd_barrier_post(unsigned* bar, volatile LAS unsigned* st) {
    XcdBarrier b; b.bar = bar; b.x = xb_xcc_id(); b.st = st;
    if (threadIdx.x == 0) (void)xb_add(&bar[XB_XCNT(b.x)], 1u);
    return b;
}
__device__ __forceinline__ void xcd_barrier_complete(unsigned* bar, unsigned x, unsigned& nloc, unsigned& nx) {
    const unsigned G = gridDim.x * gridDim.y * gridDim.z;
    unsigned sum, cnt, mine, sp = 0u;
    for (;;) {
        sum = 0u; cnt = 0u; mine = 0u;
#pragma unroll
        for (unsigned j = 0; j < 16; ++j) { const unsigned c = xb_ld(&bar[XB_XCNT(j)]); sum += c; cnt += (c > 0u) ? 1u : 0u; mine = (j == x) ? c : mine; }
        if (sum == G) break;
        __builtin_amdgcn_s_sleep(1);
        if ((++sp & 255u) == 0u) { if (xb_ld(&bar[XB_TMO])) break; if (sp > XB_SPIN_CAP) { atomicAdd(&bar[XB_TMO], 1u); break; } }
    }
    nloc = mine > 0u ? mine : 1u; nx = cnt > 0u ? cnt : 1u;
}

__device__ __forceinline__ void xcd_barrier(const XcdBarrier& b) {
    asm volatile("s_waitcnt vmcnt(0)" ::: "memory");
    __syncthreads();
    if (threadIdx.x == 0) {
        unsigned* bar = b.bar;
        __builtin_amdgcn_s_waitcnt(0);
        unsigned nloc = b.st[0], nx = b.st[1];
        if (nloc == 0u) { xcd_barrier_complete(bar, b.x, nloc, nx); b.st[0] = nloc; b.st[1] = nx; }
        const unsigned old = xb_add(&bar[XB_XSUB(b.x)], 1u);
        const unsigned gen = old / nloc;
        if (old + 1u == (gen + 1u) * nloc) {
            __builtin_amdgcn_fence(__ATOMIC_RELEASE, "agent");
            asm volatile("s_waitcnt vmcnt(0)" ::: "memory");
            const unsigned og = xb_add(&bar[XB_TOP], 1u);
            const unsigned tg = og / nx;
            if (og + 1u == (tg + 1u) * nx) xb_add(&bar[XB_TOPGEN], 1u);
            else XB_SPIN(xb_ld(&bar[XB_TOPGEN]) == tg, bar);
            __builtin_amdgcn_fence(__ATOMIC_ACQUIRE, "agent");
            xb_add(&bar[XB_XGEN(b.x)], 1u);
            asm volatile("s_waitcnt vmcnt(0)" ::: "memory");
        } else {
            XB_SPIN(xb_ld(&bar[XB_XGEN(b.x)]) == gen, bar);
            __builtin_amdgcn_fence(__ATOMIC_ACQUIRE, "agent");
            asm volatile("s_waitcnt vmcnt(0)" ::: "memory");
        }
    }
    __syncthreads();
}
namespace pg8 {
#define PG8_LAS __attribute__((address_space(3)))
typedef unsigned short bf16_t;
typedef short bf16x8 __attribute__((ext_vector_type(8)));
typedef float f32x4 __attribute__((ext_vector_type(4)));
typedef unsigned u32x4 __attribute__((ext_vector_type(4)));
constexpr int BM = 256, BK = 64, HALF = 128, HTB = HALF * BK * 2  , STAGE_BYTES = 8 * HTB, NXCD = 8, WGM = 8;

__host__ __device__ __forceinline__ int lds_byte(int r, int c) { const int st = (r >> 4) * 2 + (c >> 5), rr = r & 15, cc = c & 31, ob = rr * 64 + cc * 2; return st * 1024 + (ob ^ (((ob >> 9) & 1) << 5)); }
__host__ __device__ __forceinline__ void stage_rc(int b, int& R, int& C) { const int st = b / 1024, sb = b % 1024, swz = sb ^ (((sb >> 9) & 1) << 5); R = (st >> 1) * 16 + swz / 64; C = (st & 1) * 32 + (swz % 64) / 2; }
__host__ __device__ __forceinline__ int perm32(int rho) { const int n = rho >> 4, i = rho & 15; return 8 * (i >> 2) + 4 * n + (i & 3); }

struct Unit { int pm, pn; };
struct Gemm { const bf16_t* A; const bf16_t* Bt; int M, N, K; };

struct StaticOrder {
    int nM, nN, nwg, G, c;
    __host__ __device__ void init(int M, int N, int G_, int c_) { nM = M / BM; nN = N / BM; nwg = nM * nN; G = G_; c = c_; }
    __host__ __device__ bool next(int i, Unit& u) const {
        const long L = (long)i * G + c; if (L >= nwg) return false;
        int wgid = (int)L; { const int q = nwg / NXCD, r = nwg % NXCD, xcd = wgid % NXCD, off = wgid / NXCD; wgid = (xcd < r ? xcd * (q + 1) : r * (q + 1) + (xcd - r) * q) + off; }
        const int nig = WGM * nN, gid = wgid / nig, fm = gid * WGM, gsz = (nM - fm) < WGM ? (nM - fm) : WGM;
        u.pm = fm + ((wgid % nig) % gsz); u.pn = (wgid % nig) / gsz; return true;
    }
    __device__ __forceinline__ void a_ready(const Unit&) const {}
    __device__ __forceinline__ void done(const Unit&) const {}
};

__device__ __forceinline__ unsigned cvt_pk_bf16(float lo, float hi) { unsigned r; asm volatile("v_cvt_pk_bf16_f32 %0, %1, %2" : "=v"(r) : "v"(lo), "v"(hi)); return r; }
typedef float f32x2 __attribute__((ext_vector_type(2)));
__device__ __forceinline__ f32x2 gelu_pk(f32x2 v) {
    const f32x2 av = __builtin_elementwise_abs(v), d = av * 0.2316418882f + 1.0f;
    f32x2 t; t.x = __builtin_amdgcn_rcpf(d.x); t.y = __builtin_amdgcn_rcpf(d.y);
    f32x2 q = t * 0.5307027145f + (-0.7265760135f); q = q * t + 0.7107068705f; q = q * t + (-0.142248368f); q = q * t + 0.127414796f; q = q * t;
    const f32x2 s = (v * v) * (-0.72134752044f);
    f32x2 e; e.x = __builtin_amdgcn_exp2f(s.x); e.y = __builtin_amdgcn_exp2f(s.y);
    const f32x2 m = v * (q * e), r = v - m;
    f32x2 o; o.x = v.x < 0.f ? m.x : r.x; o.y = v.y < 0.f ? m.y : r.y; return o;
}

template <int ACT  > struct EpiBf16 {
    static constexpr bool PERM = true, AFTER_DRAIN = false; static_assert(ACT == 0 || ACT == 1, "EpiBf16: ACT is 0 (none) or 1 (gelu_pk)");
    bf16_t* O; int ldc; const float* bias; int split_cols; size_t split_stride; float scale0;
    __device__ __forceinline__ void operator()(const f32x4 (&acc)[2][2][4][2], const Unit& u, int wr, int wc, int fr, int fq) const {
        const int row0 = u.pm * BM + wr * 64 + fr; int colt = u.pn * BM; bf16_t* base = O;
        float sc = 1.f; if (split_cols) { const int t = colt / split_cols; base += (size_t)t * split_stride; colt -= t * split_cols; if (t == 0) sc = scale0; }
        const int col0 = colt + wc * 32 + 8 * fq, bcol0 = u.pn * BM + wc * 32 + 8 * fq;
        f32x4 bv[2][2];
#pragma unroll
        for (int bj = 0; bj < 2; ++bj)
#pragma unroll
            for (int n = 0; n < 2; ++n) bv[bj][n] = bias ? *(const f32x4*)(bias + bcol0 + bj * HALF + 4 * n) : (f32x4){0.f, 0.f, 0.f, 0.f};
#pragma unroll
        for (int ai = 0; ai < 2; ++ai)
#pragma unroll
            for (int m = 0; m < 4; ++m) { bf16_t* rowp = base + (size_t)(row0 + ai * HALF + m * 16) * ldc + col0;
#pragma unroll
                for (int bj = 0; bj < 2; ++bj) { f32x4 v0 = acc[ai][bj][m][0] + bv[bj][0], v1 = acc[ai][bj][m][1] + bv[bj][1];
                    if (ACT == 1) { f32x2 a = gelu_pk((f32x2){v0[0], v0[1]}), b = gelu_pk((f32x2){v0[2], v0[3]}), c = gelu_pk((f32x2){v1[0], v1[1]}), d = gelu_pk((f32x2){v1[2], v1[3]});
                        v0 = (f32x4){a.x, a.y, b.x, b.y}; v1 = (f32x4){c.x, c.y, d.x, d.y}; }
                    v0 = v0 * sc; v1 = v1 * sc; u32x4 w; w.x = cvt_pk_bf16(v0[0], v0[1]); w.y = cvt_pk_bf16(v0[2], v0[3]); w.z = cvt_pk_bf16(v1[0], v1[1]); w.w = cvt_pk_bf16(v1[2], v1[3]);
                    *(u32x4*)(rowp + bj * HALF) = w; } }
    }
};
template <class Epi, class Sched, bool ALIGN_EPI = false, bool SP2 = false>
__device__ __forceinline__ void gemm_phase(PG8_LAS unsigned char* lds, const Gemm g, const Sched& S, const Epi& E) {
    int tid = threadIdx.x; asm volatile("" : "+v"(tid));
    const int wid = __builtin_amdgcn_readfirstlane(tid >> 6), lane = tid & 63, wr = wid >> 2, wc = wid & 3, fr = lane & 15, fq = lane >> 4;
    const int K = g.K, nt = K / BK;
    unsigned voffA[2], voffB[2];
#pragma unroll
    for (int i = 0; i < 2; ++i) { int R, C; stage_rc(tid * 16 + i * 8192, R, C); const int Rb = Epi::PERM ? ((R & ~31) + perm32(R & 31)) : R;
        voffA[i] = (unsigned)(R * K + C) * 2u; voffB[i] = (unsigned)(Rb * K + C) * 2u; }
    const size_t kstep = (size_t)(BK * 2);
    const size_t hstep = (size_t)HALF * K * 2;
    const size_t tstep = 2 * hstep;
    const unsigned ldsw = (unsigned)wid * 1024u;
    const int aoff = lds_byte(wr * 64 + fr, fq * 8), boff = lds_byte(wc * 32 + fr, fq * 8);
#define PG8_SA(b, h) (((b) * 2 + (h)) * HTB)
#define PG8_SB(b, h) ((4 + (b) * 2 + (h)) * HTB)
#define PG8_STAGE(bufoff, gbase, voff) do { _Pragma("unroll") for (int _i = 0; _i < 2; ++_i) \
        __builtin_amdgcn_global_load_lds((const unsigned*)((const char*)(gbase) + (voff)[_i]), (PG8_LAS unsigned*)(lds + (bufoff) + ldsw + _i * 8192), 16, 0, 0); } while (0)
#define PG8_LDA(dst, b, h) do { _Pragma("unroll") for (int m = 0; m < 4; ++m) _Pragma("unroll") for (int k = 0; k < 2; ++k) dst[m][k] = *(const PG8_LAS bf16x8*)(lds + PG8_SA(b, h) + aoff + m * 2048 + k * 1024); } while (0)
#define PG8_LDB(dst, b, h) do { _Pragma("unroll") for (int n = 0; n < 2; ++n) _Pragma("unroll") for (int k = 0; k < 2; ++k) dst[n][k] = *(const PG8_LAS bf16x8*)(lds + PG8_SB(b, h) + boff + n * 2048 + k * 1024); } while (0)
#define PG8_MMA(ai, bj, At, Bt) do { __builtin_amdgcn_s_setprio(1); _Pragma("unroll") for (int m = 0; m < 4; ++m) _Pragma("unroll") for (int n = 0; n < 2; ++n) _Pragma("unroll") for (int k = 0; k < 2; ++k) \
        acc[ai][bj][m][n] = __builtin_amdgcn_mfma_f32_16x16x32_bf16(Bt[n][k], At[m][k], acc[ai][bj][m][n], 0, 0, 0); __builtin_amdgcn_s_setprio(0); } while (0)
#define PG8_WAIT_V(n) asm volatile("s_waitcnt vmcnt(" #n ")" ::: "memory")
#define PG8_WAIT_L(n) asm volatile("s_waitcnt lgkmcnt(" #n ")" ::: "memory")
#define PG8_BAR __builtin_amdgcn_s_barrier()
#define PG8_SCHED __builtin_amdgcn_sched_barrier(0)
    Unit cur, nxt; int ui = 0;
    if (!S.next(0, cur)) return;
    f32x4 acc[2][2][4][2];
#pragma unroll
    for (int a = 0; a < 2; ++a)
#pragma unroll
        for (int b = 0; b < 2; ++b)
#pragma unroll
            for (int m = 0; m < 4; ++m)
#pragma unroll
                for (int n = 0; n < 2; ++n) acc[a][b][m][n] = (f32x4){0.f, 0.f, 0.f, 0.f};
    bf16x8 At[4][2], B0[2][2], B1[2][2];
    const char* cA = (const char*)g.A + (size_t)cur.pm * tstep; const char* cB = (const char*)g.Bt + (size_t)cur.pn * tstep;
    S.a_ready(cur);
    if constexpr (SP2) {
        PG8_STAGE(PG8_SB(0, 0), cB, voffB); PG8_STAGE(PG8_SB(0, 1), cB + hstep, voffB); PG8_STAGE(PG8_SA(0, 0), cA, voffA); PG8_STAGE(PG8_SA(0, 1), cA + hstep, voffA);
        if (wr == 1) PG8_BAR;
        PG8_WAIT_V(2); PG8_BAR;
        PG8_STAGE(PG8_SB(1, 0), cB + kstep, voffB); PG8_STAGE(PG8_SA(1, 0), cA + kstep, voffA); PG8_STAGE(PG8_SB(1, 1), cB + hstep + kstep, voffB);
        PG8_WAIT_V(6); PG8_BAR;
    } else {
        PG8_STAGE(PG8_SB(0, 0), cB, voffB); PG8_STAGE(PG8_SA(0, 0), cA, voffA); PG8_STAGE(PG8_SB(0, 1), cB + hstep, voffB); PG8_STAGE(PG8_SA(0, 1), cA + hstep, voffA);
        if (wr == 1) PG8_BAR;
        PG8_WAIT_V(4); PG8_BAR;
        PG8_STAGE(PG8_SB(1, 0), cB + kstep, voffB); PG8_STAGE(PG8_SA(1, 0), cA + kstep, voffA); PG8_STAGE(PG8_SB(1, 1), cB + hstep + kstep, voffB);
        PG8_WAIT_V(6); PG8_BAR;
    }
    for (;;) {
        const bool has_next = S.next(ui + 1, nxt);
        const char* nA = has_next ? (const char*)g.A + (size_t)nxt.pm * tstep : cA; const char* nB = has_next ? (const char*)g.Bt + (size_t)nxt.pn * tstep : cB;
        for (int t = 0; t < nt; t += 2) {
            const bool last = (t == nt - 2);
            const char* a1 = cA + (size_t)(t + 1) * kstep;
            const char* a2 = last ? nA : cA + (size_t)(t + 2) * kstep; const char* b2 = last ? nB : cB + (size_t)(t + 2) * kstep;
            const char* a3 = a2 + kstep; const char* b3 = b2 + kstep;
            if (last && has_next) S.a_ready(nxt);
            if constexpr (SP2) {
            PG8_LDB(B0, 0, 0); PG8_LDB(B1, 0, 1); PG8_SCHED; PG8_LDA(At, 0, 0); PG8_STAGE(PG8_SA(1, 1), a1 + hstep, voffA);
            PG8_WAIT_V(8); PG8_WAIT_L(0); PG8_BAR; PG8_MMA(0, 0, At, B0); PG8_MMA(0, 1, At, B1); PG8_BAR; PG8_SCHED;
            PG8_LDA(At, 0, 1); PG8_STAGE(PG8_SB(0, 0), b2, voffB); PG8_STAGE(PG8_SB(0, 1), b2 + hstep, voffB); PG8_STAGE(PG8_SA(0, 0), a2, voffA);
            PG8_WAIT_V(8); PG8_WAIT_L(0); PG8_BAR; PG8_MMA(1, 0, At, B0); PG8_MMA(1, 1, At, B1); PG8_BAR; PG8_SCHED;
            PG8_LDB(B0, 1, 0); PG8_LDB(B1, 1, 1); PG8_SCHED; PG8_LDA(At, 1, 0); PG8_STAGE(PG8_SA(0, 1), a2 + hstep, voffA);
            PG8_WAIT_V(8); PG8_WAIT_L(0); PG8_BAR; PG8_MMA(0, 0, At, B0); PG8_MMA(0, 1, At, B1); PG8_BAR; PG8_SCHED;
            PG8_LDA(At, 1, 1); PG8_STAGE(PG8_SB(1, 0), b3, voffB); PG8_STAGE(PG8_SB(1, 1), b3 + hstep, voffB); PG8_STAGE(PG8_SA(1, 0), a3, voffA);
            PG8_WAIT_V(8); PG8_WAIT_L(0); PG8_BAR; PG8_MMA(1, 0, At, B0); PG8_MMA(1, 1, At, B1); PG8_BAR; PG8_SCHED;
            } else {
            PG8_LDB(B0, 0, 0); PG8_SCHED; PG8_LDA(At, 0, 0); PG8_STAGE(PG8_SA(1, 1), a1 + hstep, voffA);
            PG8_WAIT_L(8); PG8_BAR; PG8_WAIT_L(0); PG8_MMA(0, 0, At, B0); PG8_BAR; PG8_SCHED;
            PG8_LDB(B1, 0, 1); PG8_STAGE(PG8_SB(0, 0), b2, voffB);
            PG8_BAR; PG8_WAIT_L(0); PG8_MMA(0, 1, At, B1); PG8_BAR;
            PG8_LDA(At, 0, 1); PG8_STAGE(PG8_SA(0, 0), a2, voffA);
            PG8_BAR; PG8_WAIT_L(0); PG8_MMA(1, 0, At, B0); PG8_BAR; PG8_SCHED;
            PG8_STAGE(PG8_SB(0, 1), b2 + hstep, voffB);
            PG8_WAIT_V(6); PG8_BAR; PG8_MMA(1, 1, At, B1); PG8_BAR;
            PG8_LDB(B0, 1, 0); PG8_SCHED; PG8_LDA(At, 1, 0); PG8_STAGE(PG8_SA(0, 1), a2 + hstep, voffA);
            PG8_WAIT_L(8); PG8_BAR; PG8_WAIT_L(0); PG8_MMA(0, 0, At, B0); PG8_BAR; PG8_SCHED;
            PG8_LDB(B1, 1, 1); PG8_STAGE(PG8_SB(1, 0), b3, voffB);
            PG8_BAR; PG8_WAIT_L(0); PG8_MMA(0, 1, At, B1); PG8_BAR;
            PG8_LDA(At, 1, 1); PG8_STAGE(PG8_SA(1, 0), a3, voffA);
            PG8_BAR; PG8_WAIT_L(0); PG8_MMA(1, 0, At, B0); PG8_BAR; PG8_SCHED;
            PG8_STAGE(PG8_SB(1, 1), b3 + hstep, voffB);
            PG8_WAIT_V(6); PG8_BAR; PG8_MMA(1, 1, At, B1); PG8_BAR;
            }
        }
        if constexpr (ALIGN_EPI) { if (wr == 0) PG8_BAR; }
        if constexpr (!Epi::AFTER_DRAIN) { E(acc, cur, wr, wc, fr, fq); S.done(cur); }
        if (!has_next) break;
#pragma unroll
        for (int a = 0; a < 2; ++a)
#pragma unroll
            for (int b = 0; b < 2; ++b)
#pragma unroll
                for (int m = 0; m < 4; ++m)
#pragma unroll
                    for (int n = 0; n < 2; ++n) acc[a][b][m][n] = (f32x4){0.f, 0.f, 0.f, 0.f};
        cur = nxt; cA = nA; cB = nB; ++ui;
        if constexpr (ALIGN_EPI) { if (wr == 1) PG8_BAR; }
    }
    PG8_WAIT_V(0);
    if constexpr (!ALIGN_EPI) { if (wr == 0) PG8_BAR; }
    PG8_BAR;
    if constexpr (Epi::AFTER_DRAIN) { E.fused(acc, cur, wr, wc, fr, fq, lds, wid, lane); S.done(cur); }
#undef PG8_SA
#undef PG8_SB
#undef PG8_STAGE
#undef PG8_LDA
#undef PG8_LDB
#undef PG8_MMA
#undef PG8_WAIT_V
#undef PG8_WAIT_L
#undef PG8_BAR
#undef PG8_SCHED
}
}
namespace fk {
using pg8::bf16_t; using pg8::f32x4; using pg8::u32x4; using pg8::Unit;
typedef unsigned u32x2 __attribute__((ext_vector_type(2)));
constexpr int MP = 17664;
constexpr int FR_META = 16384, FR_SAMP = 16640;
constexpr int TPK = nv::TP;
constexpr float EPS = 1e-6f;
constexpr float C2Q = 0.07216878364870322f * 1.4426950408889634f;
constexpr int NTHREADS = 512, NWAVES = 8;

struct P {
    const float *x_prompt, *x_sample, *cache_ckv, *cache_kr, *st_re, *st_im, *st_conv; const int* page_table;
    const float *meta, *g_mix, *w_in, *g_q, *w_uq, *g_kv, *w_uk, *w_uv, *a_re, *a_im, *log_dt, *b_re, *b_im, *c_re, *c_im, *s5_d, *w_glu, *w_out, *g_ffn, *w_gate, *w_up, *conv_w, *conv_b, *w_down, *g_final;
    float* out;
    unsigned* ctl;
    bf16_t *Bt_in, *Bt_uq, *Bt_kv, *Bt_glu, *Bt_out, *Bt_gu, *Bt_down;
    float *rope_cos, *rope_sin, *abar_re, *abar_im, *bbar_re, *bbar_im;
    bf16_t *XN, *U, *CQ, *CKVB, *QB, *KB, *VB, *YS, *CAT, *X1B, *H, *UPB;
    float *CKVF, *SSQKV, *SSQQ, *X1, *SSQ1, *GATE, *X2, *APART;
    bf16_t *UG2, *Bt_S, *Bt_Y; float *APOW, *KG, *SC, *HM;
};
struct Carver { char* p; template <class T> T* take(size_t n) { T* r = (T*)p; p += (n * sizeof(T) + 255) / 256 * 256; return r; } };
inline void carve(P& q, char* base) {
    Carver c{base};
    q.ctl = c.take<unsigned>(1 << 18);
    q.Bt_in = c.take<bf16_t>((size_t)1280 * 1024); q.Bt_uq = c.take<bf16_t>((size_t)768 * 384); q.Bt_kv = c.take<bf16_t>((size_t)1024 * 256);
    q.Bt_glu = c.take<bf16_t>((size_t)512 * 512); q.Bt_out = c.take<bf16_t>((size_t)1024 * 1024); q.Bt_gu = c.take<bf16_t>((size_t)5632 * 1024); q.Bt_down = c.take<bf16_t>((size_t)1024 * 2816);
    q.rope_cos = c.take<float>(4120 * 32); q.rope_sin = c.take<float>(4120 * 32); q.abar_re = c.take<float>(2048); q.abar_im = c.take<float>(2048); q.bbar_re = c.take<float>(32768); q.bbar_im = c.take<float>(32768);
    q.XN = c.take<bf16_t>((size_t)MP * 1024); q.U = c.take<bf16_t>((size_t)MP * 512); q.CQ = c.take<bf16_t>((size_t)MP * 384); q.CKVB = c.take<bf16_t>((size_t)MP * 256);
    q.QB = c.take<bf16_t>((size_t)MP * 768); q.KB = c.take<bf16_t>((size_t)MP * 768); q.VB = c.take<bf16_t>((size_t)MP * 512); q.YS = c.take<bf16_t>((size_t)MP * 512);
    q.CAT = c.take<bf16_t>((size_t)MP * 1024); q.X1B = c.take<bf16_t>((size_t)MP * 1024); q.H = c.take<bf16_t>((size_t)MP * 2816); q.UPB = c.take<bf16_t>((size_t)MP * 2816);
    q.CKVF = c.take<float>((size_t)MP * 256); q.SSQKV = c.take<float>((size_t)MP * 4); q.SSQQ = c.take<float>((size_t)MP * 8); q.X1 = c.take<float>((size_t)MP * 1024);
    q.SSQ1 = c.take<float>((size_t)MP * 16); q.GATE = c.take<float>((size_t)MP * 2816); q.X2 = c.take<float>((size_t)MP * 1024); q.APART = c.take<float>((size_t)256 * (32 * 256 + 64));
    q.UG2 = c.take<bf16_t>((size_t)32 * 512 * 640); q.Bt_S = c.take<bf16_t>((size_t)32 * 256 * 640); q.Bt_Y = c.take<bf16_t>((size_t)32 * 512 * 640);
    q.APOW = c.take<float>((size_t)2048 * 33 * 2); q.KG = c.take<float>((size_t)32 * 32 * 256); q.SC = c.take<float>((size_t)32 * 512 * 128); q.HM = c.take<float>(32 * 128);
}
inline void fill_inputs(P& q, void* const* d_in, float* out) {
    q.x_prompt = (const float*)d_in[0]; q.x_sample = (const float*)d_in[1]; q.cache_ckv = (const float*)d_in[2]; q.cache_kr = (const float*)d_in[3];
    q.st_re = (const float*)d_in[4]; q.st_im = (const float*)d_in[5]; q.st_conv = (const float*)d_in[6]; q.page_table = (const int*)d_in[7];
    q.meta = (const float*)d_in[8]; q.g_mix = (const float*)d_in[9]; q.w_in = (const float*)d_in[10]; q.g_q = (const float*)d_in[11];
    q.w_uq = (const float*)d_in[12]; q.g_kv = (const float*)d_in[13]; q.w_uk = (const float*)d_in[14]; q.w_uv = (const float*)d_in[15];
    q.a_re = (const float*)d_in[16]; q.a_im = (const float*)d_in[17]; q.log_dt = (const float*)d_in[18]; q.b_re = (const float*)d_in[19];
    q.b_im = (const float*)d_in[20]; q.c_re = (const float*)d_in[21]; q.c_im = (const float*)d_in[22]; q.s5_d = (const float*)d_in[23];
    q.w_glu = (const float*)d_in[24]; q.w_out = (const float*)d_in[25]; q.g_ffn = (const float*)d_in[26]; q.w_gate = (const float*)d_in[27];
    q.w_up = (const float*)d_in[28]; q.conv_w = (const float*)d_in[29]; q.conv_b = (const float*)d_in[30]; q.w_down = (const float*)d_in[31];
    q.g_final = (const float*)d_in[32]; q.out = out;
}

__device__ __forceinline__ int fresh_tid() { int t = threadIdx.x; asm volatile("" : "+v"(t)); return t; }
__device__ __forceinline__ int fr_posidx(int fr) { return fr < FR_META ? (fr & 4095) + 16 : (fr < FR_SAMP ? (fr - FR_META) & 15 : TPK + ((fr - FR_SAMP) & 7)); }
__device__ __forceinline__ unsigned pk2(float lo, float hi) { return pg8::cvt_pk_bf16(lo, hi); }
__device__ __forceinline__ float bf2f(bf16_t v) { return __uint_as_float((unsigned)v << 16); }
__device__ __forceinline__ float wsum(float v) {
#pragma unroll
    for (int o = 1; o < 64; o <<= 1) v += __shfl_xor(v, o);
    return v;
}

__device__ __forceinline__ void conv_item(const float* W, int ldw, int c0, const float* gk, int k0, bf16_t* Bt, int K, int n0, LAS float* scr, int lane) {
#pragma unroll 8
    for (int i = 0; i < 32; ++i) { const int kk = 2 * i + (lane >> 5); float v = 0.f;
        if (c0 >= 0) { v = W[(size_t)(k0 + kk) * ldw + c0 + (lane & 31)]; if (gk) v *= gk[k0 + kk]; }
        scr[kk * 33 + (lane & 31)] = v; }
    LDS_WAIT(); asm volatile("" ::: "memory");
    const int c = lane & 7;
#pragma unroll
    for (int j = 0; j < 4; ++j) { const int n = (lane >> 3) + 8 * j; const LAS float* s = scr + (8 * c) * 33 + n;
        v4u o; o.x = pk2(s[0 * 33], s[1 * 33]); o.y = pk2(s[2 * 33], s[3 * 33]); o.z = pk2(s[4 * 33], s[5 * 33]); o.w = pk2(s[6 * 33], s[7 * 33]);
        *(GAS v4u*)(Bt + (size_t)(n0 + n) * K + k0 + 8 * c) = o; }
    LDS_WAIT(); asm volatile("" ::: "memory");
}
__device__ __forceinline__ int in_colmap(int nb) {
    if (nb < 16) return 32 * nb;
    if (nb < 24) return 896 + 32 * (nb - 16);
    if (nb < 32) return 512 + 32 * (nb - 24);
    if (nb == 32) return 1152;
    if (nb < 36) return 768 + 32 * (nb - 33);
    if (nb == 36) return 1184;
    if (nb == 37) return 864;
    return -1;
}
__device__ __forceinline__ int uq_colmap(int nb) {
    if (nb < 16) return 192 * (nb >> 2) + 32 * (nb & 3);
    if (nb < 20) return 192 * (nb - 16) + 128;
    return 192 * (nb - 20) + 160;
}
constexpr int IT_IN = 40 * 16, IT_UQ = 24 * 6, IT_KV = 32 * 4, IT_GLU = 16 * 8, IT_OUT = 32 * 16, IT_GU = 176 * 16, IT_DN = 32 * 44;
constexpr int IT_TOTAL = IT_IN + IT_UQ + IT_KV + IT_GLU + IT_OUT + IT_GU + IT_DN;
__device__ __forceinline__ void prologue(const P& p, LAS unsigned char* lds, int vcu, int G) {
    const int tid = fresh_tid(), lane = tid & 63, wave = tid >> 6;
    LAS float* scr = (LAS float*)(lds + wave * 16384);
    const int gw = vcu * NWAVES + wave, NGW = G * NWAVES;
    for (int it = gw; it < IT_TOTAL; it += NGW) {
        int r = it;
        if (r < IT_IN) { const int nb = r % 40, kb = r / 40; conv_item(p.w_in, 1216, in_colmap(nb), nullptr, 64 * kb, p.Bt_in, 1024, 32 * nb, scr, lane); continue; } r -= IT_IN;
        if (r < IT_UQ) { const int nb = r % 24, kb = r / 24; conv_item(p.w_uq, 768, uq_colmap(nb), p.g_q, 64 * kb, p.Bt_uq, 384, 32 * nb, scr, lane); continue; } r -= IT_UQ;
        if (r < IT_KV) { const int nb = r % 32, kb = r / 32; conv_item(nb < 16 ? p.w_uk : p.w_uv, 512, 32 * (nb & 15), p.g_kv, 64 * kb, p.Bt_kv, 256, 32 * nb, scr, lane); continue; } r -= IT_KV;
        if (r < IT_GLU) { const int nb = r % 16, kb = r / 16; conv_item(p.w_glu, 512, 32 * nb, nullptr, 64 * kb, p.Bt_glu, 512, 32 * nb, scr, lane); continue; } r -= IT_GLU;
        if (r < IT_OUT) { const int nb = r % 32, kb = r / 32; conv_item(p.w_out, 1024, 32 * nb, nullptr, 64 * kb, p.Bt_out, 1024, 32 * nb, scr, lane); continue; } r -= IT_OUT;
        if (r < IT_GU) { const int nb = r % 176, kb = r / 176, pn = nb >> 3, nl = nb & 7;
            conv_item(nl < 4 ? p.w_gate : p.w_up, 2816, 128 * pn + 32 * (nl & 3), p.g_ffn, 64 * kb, p.Bt_gu, 1024, 32 * nb, scr, lane); continue; } r -= IT_GU;
        { const int nb = r % 32, kb = r / 32; conv_item(p.w_down, 1024, 32 * nb, nullptr, 64 * kb, p.Bt_down, 2816, 32 * nb, scr, lane); }
    }
    for (int fr = gw; fr < MP; fr += NGW) {
        const float* src = nullptr;
        if (fr < FR_META) src = p.x_prompt + (size_t)fr * 1024;
        else if (fr < FR_META + 16) src = p.meta + (size_t)(fr - FR_META) * 1024;
        else if (fr >= FR_SAMP) src = p.x_sample + (size_t)(fr - FR_SAMP) * 1024;
        GAS unsigned long long* o8 = (GAS unsigned long long*)(p.XN + (size_t)fr * 1024) + lane;
        if (!src) {
#pragma unroll
            for (int j = 0; j < 4; ++j) o8[64 * j] = 0ull;
            continue; }
        const GAS f32x4* xr = (const GAS f32x4*)src + lane; const GAS f32x4* gr = (const GAS f32x4*)p.g_mix + lane;
        f32x4 v[4]; float s = 0.f;
#pragma unroll
        for (int j = 0; j < 4; ++j) { v[j] = xr[64 * j]; s += (v[j].x * v[j].x + v[j].y * v[j].y) + (v[j].z * v[j].z + v[j].w * v[j].w); }
        const float rs = 1.0f / sqrtf(wsum(s) * (1.0f / 1024.0f) + EPS);
#pragma unroll
        for (int j = 0; j < 4; ++j) { const f32x4 g = gr[64 * j]; const f32x4 y = v[j] * rs * g;
            o8[64 * j] = (unsigned long long)pk2(y.x, y.y) | ((unsigned long long)pk2(y.z, y.w) << 32); }
    }
    const int gid = vcu * NTHREADS + tid, nth = G * NTHREADS;
    for (int i = gid; i < 4120 * 32; i += nth) {
        const int pi = i >> 5, f = i & 31; const int pos = pi < TPK ? pi : nv::PAST_LEN + (pi - TPK);
        const double inv = pow(10000.0, -(double)f / 32.0), ang = (double)pos * inv;
        p.rope_cos[i] = (float)cos(ang); p.rope_sin[i] = (float)sin(ang);
    }
    for (int i = gid; i < 2048; i += nth) {
        const int g = i >> 6;
        const double dt = exp((double)p.log_dt[g]), ar = p.a_re[i], ai = p.a_im[i];
        const double mag = exp(dt * ar), cr = mag * cos(dt * ai), ci = mag * sin(dt * ai);
        const double nr = cr - 1.0, ni = ci, den = ar * ar + ai * ai;
        const double fr_ = (nr * ar + ni * ai) / den, fi = (ni * ar - nr * ai) / den;
        p.abar_re[i] = (float)cr; p.abar_im[i] = (float)ci;
        for (int j = 0; j < 16; ++j) { const double br = p.b_re[i * 16 + j], bi = p.b_im[i * 16 + j];
            p.bbar_re[i * 16 + j] = (float)(fr_ * br - fi * bi); p.bbar_im[i * 16 + j] = (float)(fr_ * bi + fi * br); }
    }
}

__device__ __forceinline__ void st_bf4(bf16_t* dst, f32x4 v) { u32x2 w; w.x = pk2(v[0], v[1]); w.y = pk2(v[2], v[3]); *(u32x2*)dst = w; }
__device__ __forceinline__ float sq4(f32x4 v) { return (v[0] * v[0] + v[1] * v[1]) + (v[2] * v[2] + v[3] * v[3]); }

struct EpiIn {
    static constexpr bool PERM = false, AFTER_DRAIN = false;
    P p;
    __device__ __forceinline__ void operator()(const f32x4 (&acc)[2][2][4][2], const Unit& u, int wr, int wc, int fr, int fq) const {
        { const int t_ = fresh_tid(); fr = t_ & 15; fq = (t_ >> 4) & 3; }
        const int pm = u.pm, pn = u.pn;
#pragma unroll
        for (int ai = 0; ai < 2; ++ai)
#pragma unroll
            for (int m = 0; m < 4; ++m) {
                const int row = pm * 256 + ai * 128 + wr * 64 + m * 16 + fr;
                if (pn < 2) {
#pragma unroll
                    for (int bj = 0; bj < 2; ++bj)
#pragma unroll
                        for (int n = 0; n < 2; ++n) { const int ch = pn * 256 + bj * 128 + wc * 32 + n * 16 + 4 * fq; st_bf4(p.U + (size_t)row * 512 + ch, acc[ai][bj][m][n]);
                            if (pm < 64) st_bf4(p.UG2 + ((size_t)(ch >> 4) * 512 + (row >> 5)) * 640 + (row & 31) * 16 + (ch & 15), acc[ai][bj][m][n]); }
                } else if (pn == 2 || pn == 3) {
                    float s = 0.f;
#pragma unroll
                    for (int bj = 0; bj < 2; ++bj)
#pragma unroll
                        for (int n = 0; n < 2; ++n) { const f32x4 v = acc[ai][bj][m][n]; s += sq4(v); const int c = bj * 128 + wc * 32 + n * 16 + 4 * fq;
                            if (pn == 2) { *(f32x4*)(p.CKVF + (size_t)row * 256 + c) = v; st_bf4(p.CKVB + (size_t)row * 256 + c, v); }
                            else st_bf4(p.CQ + (size_t)row * 384 + c, v); }
                    s += __shfl_xor(s, 16); s += __shfl_xor(s, 32);
                    if (fq == 0) { if (pn == 2) p.SSQKV[(size_t)row * 4 + wc] = s; else p.SSQQ[(size_t)row * 8 + wc] = s; }
                } else {
                    if (wc == 0) {
                        const int pi = fr_posidx(row);
#pragma unroll
                        for (int n = 0; n < 2; ++n) { const int i = n * 16 + 4 * fq;
                            const f32x4 c = *(const f32x4*)(p.rope_cos + pi * 32 + i), s = *(const f32x4*)(p.rope_sin + pi * 32 + i);
                            const f32x4 x1 = acc[ai][0][m][n], x2 = acc[ai][1][m][n];
                            const f32x4 y1 = x1 * c - x2 * s, y2 = x1 * s + x2 * c;
                            if (pm < 64) { const int b = row >> 12, tq = row & 4095; float* o = p.out + nv::O_KRP + ((size_t)b * TPK + 16 + tq) * 64 + i; *(f32x4*)o = y1; *(f32x4*)(o + 32) = y2; }
                            else if (pm == 64) { if (row < FR_META + 16) { const int t = row - FR_META;
#pragma unroll
                                    for (int b = 0; b < 4; ++b) { float* o = p.out + nv::O_KRP + ((size_t)b * TPK + t) * 64 + i; *(f32x4*)o = y1; *(f32x4*)(o + 32) = y2; } } }
                            else { float* o = p.out + nv::O_KRS + (size_t)(row - FR_SAMP) * 64 + i; *(f32x4*)o = y1; *(f32x4*)(o + 32) = y2; }
                            if (pm <= 64) {
#pragma unroll
                                for (int h = 0; h < 4; ++h) { bf16_t* kb = p.KB + ((size_t)row * 4 + h) * 192 + 128 + i; st_bf4(kb, y1); st_bf4(kb + 32, y2); } }
                        }
                        if (fq == 0) p.SSQQ[(size_t)row * 8 + 4] = 0.f;
                    } else {
                        float s = 0.f;
#pragma unroll
                        for (int n = 0; n < 2; ++n) { const f32x4 v = acc[ai][0][m][n]; s += sq4(v); st_bf4(p.CQ + (size_t)row * 384 + 256 + 32 * (wc - 1) + n * 16 + 4 * fq, v); }
                        if (wc == 1) {
#pragma unroll
                            for (int n = 0; n < 2; ++n) { const f32x4 v = acc[ai][1][m][n]; s += sq4(v); st_bf4(p.CQ + (size_t)row * 384 + 352 + n * 16 + 4 * fq, v); } }
                        s += __shfl_xor(s, 16); s += __shfl_xor(s, 32);
                        if (fq == 0) p.SSQQ[(size_t)row * 8 + 4 + wc] = s;
                    }
                }
                asm volatile("" ::: "memory");
            }
    }
};
__device__ __forceinline__ float rstd_q(const P& p, int row) { const f32x4 a = *(const f32x4*)(p.SSQQ + (size_t)row * 8), b = *(const f32x4*)(p.SSQQ + (size_t)row * 8 + 4);
    return 1.0f / sqrtf(((a[0] + a[1]) + (a[2] + a[3]) + (b[0] + b[1]) + (b[2] + b[3])) * (1.0f / 384.0f) + EPS); }
__device__ __forceinline__ float rstd_kv(const P& p, int row) { const f32x4 a = *(const f32x4*)(p.SSQKV + (size_t)row * 4);
    return 1.0f / sqrtf(((a[0] + a[1]) + (a[2] + a[3])) * (1.0f / 256.0f) + EPS); }

struct EpiQ {
    static constexpr bool PERM = false, AFTER_DRAIN = false;
    P p;
    __device__ __forceinline__ void operator()(const f32x4 (&acc)[2][2][4][2], const Unit& u, int wr, int wc, int fr, int fq) const {
        { const int t_ = fresh_tid(); fr = t_ & 15; fq = (t_ >> 4) & 3; }
        const int pm = u.pm, pn = u.pn;
#pragma unroll
        for (int ai = 0; ai < 2; ++ai)
#pragma unroll
            for (int m = 0; m < 4; ++m) {
                const int row = pm * 256 + ai * 128 + wr * 64 + m * 16 + fr;
                const float rs = rstd_q(p, row) * C2Q;
                if (pn < 2) {
#pragma unroll
                    for (int bj = 0; bj < 2; ++bj)
#pragma unroll
                        for (int n = 0; n < 2; ++n) st_bf4(p.QB + ((size_t)row * 4 + 2 * pn + bj) * 192 + wc * 32 + n * 16 + 4 * fq, acc[ai][bj][m][n] * rs);
                } else {
                    const int pi = fr_posidx(row);
#pragma unroll
                    for (int n = 0; n < 2; ++n) { const int i = n * 16 + 4 * fq;
                        const f32x4 c = *(const f32x4*)(p.rope_cos + pi * 32 + i), s = *(const f32x4*)(p.rope_sin + pi * 32 + i);
                        const f32x4 x1 = acc[ai][0][m][n] * rs, x2 = acc[ai][1][m][n] * rs;
                        bf16_t* q = p.QB + ((size_t)row * 4 + wc) * 192 + 128 + i; st_bf4(q, x1 * c - x2 * s); st_bf4(q + 32, x1 * s + x2 * c);
                        asm volatile("" ::: "memory"); }
                }
                asm volatile("" ::: "memory");
            }
    }
};
struct EpiKV {
    static constexpr bool PERM = false, AFTER_DRAIN = false;
    P p;
    __device__ __forceinline__ void operator()(const f32x4 (&acc)[2][2][4][2], const Unit& u, int wr, int wc, int fr, int fq) const {
        { const int t_ = fresh_tid(); fr = t_ & 15; fq = (t_ >> 4) & 3; }
        const int pm = u.pm, pn = u.pn;
#pragma unroll
        for (int ai = 0; ai < 2; ++ai)
#pragma unroll
            for (int m = 0; m < 4; ++m) {
                const int row = pm * 256 + ai * 128 + wr * 64 + m * 16 + fr;
                const float rs = rstd_kv(p, row);
#pragma unroll
                for (int bj = 0; bj < 2; ++bj)
#pragma unroll
                    for (int n = 0; n < 2; ++n) { const int j = wc * 32 + n * 16 + 4 * fq; const f32x4 v = acc[ai][bj][m][n] * rs;
                        if (pn < 2) st_bf4(p.KB + ((size_t)row * 4 + 2 * pn + bj) * 192 + j, v);
                        else st_bf4(p.VB + ((size_t)row * 4 + 2 * (pn - 2) + bj) * 128 + j, v); }
                asm volatile("" ::: "memory");
            }
    }
};
__device__ __forceinline__ void ckv_fixup(const P& p, int vcu, int G) {
    const int tid = fresh_tid(), lane = tid & 63, wave = tid >> 6; const int gw = vcu * NWAVES + wave, NGW = G * NWAVES;
    const f32x4 g = *(const f32x4*)(p.g_kv + 4 * lane);
    for (int fr = gw; fr < MP; fr += NGW) {
        if (fr >= FR_META + 16 && fr < FR_SAMP) continue;
        const float rs = rstd_kv(p, fr); const f32x4 v = *(const f32x4*)(p.CKVF + (size_t)fr * 256 + 4 * lane) * rs * g;
        if (fr < FR_META) { const int b = fr >> 12, tq = fr & 4095; *(f32x4*)(p.out + nv::O_CKVP + ((size_t)b * TPK + 16 + tq) * 256 + 4 * lane) = v; }
        else if (fr < FR_SAMP) { const int t = fr - FR_META;
#pragma unroll
            for (int b = 0; b < 4; ++b) *(f32x4*)(p.out + nv::O_CKVP + ((size_t)b * TPK + t) * 256 + 4 * lane) = v; }
        else *(f32x4*)(p.out + nv::O_CKVS + (size_t)(fr - FR_SAMP) * 256 + 4 * lane) = v;
    }
}
}
namespace fk {
__device__ __forceinline__ const float* x0_row(const P& p, int fr) {
    if (fr < FR_META) return p.x_prompt + (size_t)fr * 1024;
    if (fr < FR_SAMP) return p.meta + (size_t)((fr - FR_META) & 15) * 1024;
    return p.x_sample + (size_t)(fr - FR_SAMP) * 1024;
}
struct EpiGLU {
    static constexpr bool PERM = false, AFTER_DRAIN = false;
    P p;
    __device__ __forceinline__ void operator()(const f32x4 (&acc)[2][2][4][2], const Unit& u, int wr, int wc, int fr, int fq) const {
        { const int t_ = fresh_tid(); fr = t_ & 15; fq = (t_ >> 4) & 3; }
#pragma unroll
        for (int ai = 0; ai < 2; ++ai)
#pragma unroll
            for (int m = 0; m < 4; ++m) {
                const int row = u.pm * 256 + ai * 128 + wr * 64 + m * 16 + fr;
#pragma unroll
                for (int bj = 0; bj < 2; ++bj)
#pragma unroll
                    for (int n = 0; n < 2; ++n) { const int c = u.pn * 256 + bj * 128 + wc * 32 + n * 16 + 4 * fq;
                        const u32x2 yb = *(const u32x2*)(p.YS + (size_t)row * 512 + c); const f32x4 a = acc[ai][bj][m][n];
                        f32x4 y; y[0] = __uint_as_float(yb.x << 16); y[1] = __uint_as_float(yb.x & 0xffff0000u); y[2] = __uint_as_float(yb.y << 16); y[3] = __uint_as_float(yb.y & 0xffff0000u);
                        f32x4 o;
#pragma unroll
                        for (int e = 0; e < 4; ++e) o[e] = y[e] * __builtin_amdgcn_rcpf(1.0f + __builtin_amdgcn_exp2f(-1.4426950408889634f * a[e]));
                        st_bf4(p.CAT + (size_t)row * 1024 + c, o); }
                asm volatile("" ::: "memory");
            }
    }
};
struct EpiOut {
    static constexpr bool PERM = false, AFTER_DRAIN = false;
    P p;
    __device__ __forceinline__ void operator()(const f32x4 (&acc)[2][2][4][2], const Unit& u, int wr, int wc, int fr, int fq) const {
        { const int t_ = fresh_tid(); fr = t_ & 15; fq = (t_ >> 4) & 3; }
#pragma unroll
        for (int ai = 0; ai < 2; ++ai)
#pragma unroll
            for (int m = 0; m < 4; ++m) {
                const int row = u.pm * 256 + ai * 128 + wr * 64 + m * 16 + fr; const float* xr = x0_row(p, row); float s = 0.f;
#pragma unroll
                for (int bj = 0; bj < 2; ++bj)
#pragma unroll
                    for (int n = 0; n < 2; ++n) { const int c = u.pn * 256 + bj * 128 + wc * 32 + n * 16 + 4 * fq;
                        const f32x4 v = *(const f32x4*)(xr + c) + acc[ai][bj][m][n]; s += sq4(v);
                        *(f32x4*)(p.X1 + (size_t)row * 1024 + c) = v; st_bf4(p.X1B + (size_t)row * 1024 + c, v); }
                s += __shfl_xor(s, 16); s += __shfl_xor(s, 32);
                if (fq == 0) p.SSQ1[(size_t)row * 16 + u.pn * 4 + wc] = s;
                asm volatile("" ::: "memory");
            }
    }
};
__device__ __forceinline__ float rstd_1(const P& p, int row) { const f32x4* q = (const f32x4*)(p.SSQ1 + (size_t)row * 16); const f32x4 a = q[0] + q[1] + q[2] + q[3];
    return 1.0f / sqrtf(((a[0] + a[1]) + (a[2] + a[3])) * (1.0f / 1024.0f) + EPS); }
struct EpiGU1 {
    static constexpr bool PERM = false, AFTER_DRAIN = false;
    P p;
    __device__ __forceinline__ void operator()(const f32x4 (&acc)[2][2][4][2], const Unit& u, int wr, int wc, int fr, int fq) const {
        { const int t_ = fresh_tid(); fr = t_ & 15; fq = (t_ >> 4) & 3; }
#pragma unroll
        for (int ai = 0; ai < 2; ++ai)
#pragma unroll
            for (int m = 0; m < 4; ++m) {
                const int row = u.pm * 256 + ai * 128 + wr * 64 + m * 16 + fr; const float rs = rstd_1(p, row);
#pragma unroll
                for (int n = 0; n < 2; ++n) { const int f = u.pn * 128 + wc * 32 + n * 16 + 4 * fq;
                    *(f32x4*)(p.GATE + (size_t)row * 2816 + f) = acc[ai][0][m][n] * rs; st_bf4(p.UPB + (size_t)row * 2816 + f, acc[ai][1][m][n] * rs); }
                asm volatile("" ::: "memory");
            }
    }
};
__device__ __forceinline__ void conv_pass(const P& p, int vcu, int G) {
    const int gid = vcu * NTHREADS + fresh_tid(), nth = G * NTHREADS;
    for (int i = gid; i < MP * 704; i += nth) { const int fr = i / 704, f = (i % 704) * 4;
        if (fr >= FR_META + 16 && fr < FR_SAMP) { *(u32x2*)(p.H + (size_t)fr * 2816 + f) = (u32x2){0u, 0u}; continue; }
        const f32x4 g2 = *(const f32x4*)(p.GATE + (size_t)fr * 2816 + f); f32x4 g1, g0; const f32x4 z = {0.f, 0.f, 0.f, 0.f};
        if (fr < FR_META) { const int tq = fr & 4095;
            g1 = *(const f32x4*)(p.GATE + (size_t)(tq >= 1 ? fr - 1 : FR_META + 15) * 2816 + f);
            g0 = *(const f32x4*)(p.GATE + (size_t)(tq >= 2 ? fr - 2 : FR_META + 14 + tq) * 2816 + f); }
        else if (fr < FR_SAMP) { const int t = fr - FR_META;
            g1 = t >= 1 ? *(const f32x4*)(p.GATE + (size_t)(fr - 1) * 2816 + f) : z; g0 = t >= 2 ? *(const f32x4*)(p.GATE + (size_t)(fr - 2) * 2816 + f) : z; }
        else { const int s = fr - FR_SAMP, db = s >> 3, ts = s & 7;
            g1 = ts >= 1 ? *(const f32x4*)(p.GATE + (size_t)(fr - 1) * 2816 + f) : *(const f32x4*)(p.st_conv + ((size_t)db * 2 + 1) * 2816 + f);
            g0 = ts >= 2 ? *(const f32x4*)(p.GATE + (size_t)(fr - 2) * 2816 + f) : *(const f32x4*)(p.st_conv + ((size_t)db * 2 + ts) * 2816 + f); }
        const f32x4 w0 = *(const f32x4*)(p.conv_w + f), w1 = *(const f32x4*)(p.conv_w + 2816 + f), w2 = *(const f32x4*)(p.conv_w + 5632 + f), cb = *(const f32x4*)(p.conv_b + f);
        const u32x2 ub = *(const u32x2*)(p.UPB + (size_t)fr * 2816 + f);
        f32x4 up; up[0] = __uint_as_float(ub.x << 16); up[1] = __uint_as_float(ub.x & 0xffff0000u); up[2] = __uint_as_float(ub.y << 16); up[3] = __uint_as_float(ub.y & 0xffff0000u);
        const f32x4 c = cb + w0 * g0 + w1 * g1 + w2 * g2; f32x4 h;
#pragma unroll
        for (int e = 0; e < 4; ++e) h[e] = c[e] * __builtin_amdgcn_rcpf(1.0f + __builtin_amdgcn_exp2f(-1.4426950408889634f * c[e])) * up[e];
        st_bf4(p.H + (size_t)fr * 2816 + f, h);
        if (fr < FR_META) { const int b = fr >> 12, tq = fr & 4095; if (tq >= 4094) *(f32x4*)(p.out + nv::O_CONVP + ((size_t)b * 2 + (tq - 4094)) * 2816 + f) = g2; }
        else if (fr >= FR_SAMP) { const int s = fr - FR_SAMP, db = s >> 3, ts = s & 7; if (ts >= 6) *(f32x4*)(p.out + nv::O_CONVS + ((size_t)db * 2 + (ts - 6)) * 2816 + f) = g2; }
    }
}
struct EpiDown1 {
    static constexpr bool PERM = false, AFTER_DRAIN = false;
    P p;
    __device__ __forceinline__ void operator()(const f32x4 (&acc)[2][2][4][2], const Unit& u, int wr, int wc, int fr, int fq) const {
        { const int t_ = fresh_tid(); fr = t_ & 15; fq = (t_ >> 4) & 3; }
#pragma unroll
        for (int ai = 0; ai < 2; ++ai)
#pragma unroll
            for (int m = 0; m < 4; ++m) {
                const int row = u.pm * 256 + ai * 128 + wr * 64 + m * 16 + fr;
#pragma unroll
                for (int bj = 0; bj < 2; ++bj)
#pragma unroll
                    for (int n = 0; n < 2; ++n) { const size_t o = (size_t)row * 1024 + u.pn * 256 + bj * 128 + wc * 32 + n * 16 + 4 * fq;
                        *(f32x4*)(p.X2 + o) = *(const f32x4*)(p.X1 + o) + acc[ai][bj][m][n]; }
                asm volatile("" ::: "memory");
            }
    }
};
__device__ __forceinline__ void final_pass(const P& p, int vcu, int G) {
    const int tid_ = fresh_tid(), lane = tid_ & 63, wave = tid_ >> 6; const int gw = vcu * NWAVES + wave, NGW = G * NWAVES;
    for (int fr = gw; fr < MP; fr += NGW) {
        float* dst;
        if (fr < FR_META) dst = p.out + nv::O_YP + (size_t)fr * 1024; else if (fr >= FR_SAMP) dst = p.out + nv::O_YS + (size_t)(fr - FR_SAMP) * 1024; else continue;
        const f32x4* xr = (const f32x4*)(p.X2 + (size_t)fr * 1024) + lane; const f32x4* gr = (const f32x4*)p.g_final + lane;
        f32x4 v[4]; float s = 0.f;
#pragma unroll
        for (int j = 0; j < 4; ++j) { v[j] = xr[64 * j]; s += sq4(v[j]); }
        const float rs = 1.0f / sqrtf(wsum(s) * (1.0f / 1024.0f) + EPS);
#pragma unroll
        for (int j = 0; j < 4; ++j) ((f32x4*)dst + lane)[64 * j] = v[j] * rs * gr[64 * j];
    }
}
}
namespace fk {
typedef short s16x4 __attribute__((ext_vector_type(4)));
typedef float f32x16 __attribute__((ext_vector_type(16)));
#define FK_SBAR() __builtin_amdgcn_sched_barrier(0)
constexpr int AT_KROW = 400;
constexpr int AT_KHALF = 64 * AT_KROW;
constexpr int AT_VOFF = 2 * AT_KHALF;
constexpr int AT_VHALF = 64 * 128 * 2;
constexpr int AT_WS = AT_VOFF + 2 * AT_VHALF;
constexpr int AT_LDS = AT_WS + 8 * 64 * 4;
__device__ __forceinline__ int v_st(int k, int c) { const int kk = (k & ~0xC) | ((k & 4) << 1) | ((k & 8) >> 1); return ((kk >> 3) * 4 + (c >> 5)) * 512 + ((kk & 7) * 32 + (c & 31)) * 2; }
__device__ __forceinline__ int v_rd_base(int lane) { return ((lane & 3) << 3) | (((lane >> 2) & 3) << 6) | (((lane >> 4) & 1) << 5) | (((lane >> 5) & 1) << 8); }
constexpr int v_rd_off(int d0, int ks, int half) { return d0 * 512 + ks * 4096 + half * 2048; }
__device__ __forceinline__ int crow(int r, int hi) { return (r & 3) + 8 * (r >> 2) + 4 * hi; }
__device__ __forceinline__ unsigned cvtpk(float lo, float hi) { unsigned r; asm volatile("v_cvt_pk_bf16_f32 %0, %1, %2" : "=v"(r) : "v"(lo), "v"(hi)); return r; }
__device__ __forceinline__ void mask_tile(f32x16& p0, f32x16& p1, int dq, unsigned W) {
    const float NEG = -__builtin_inff();
#pragma unroll
    for (int r = 0; r < 16; ++r) { const int c = (r & 3) + 8 * (r >> 2);
        if ((unsigned)(dq - c) >= W) p0[r] = NEG;
        if ((unsigned)(dq - c - 32) >= W) p1[r] = NEG; }
}
constexpr float AT_THR = 8.f;
__device__ __forceinline__ void partialSM(f32x16& p0, f32x16& p1, float& m_reg, float& alpha) {
    float pmax = p0[0];
#pragma unroll
    for (int r = 1; r < 16; ++r) pmax = fmaxf(pmax, p0[r]);
#pragma unroll
    for (int r = 0; r < 16; ++r) pmax = fmaxf(pmax, p1[r]);
    { auto rr = __builtin_amdgcn_permlane32_swap(__float_as_uint(pmax), __float_as_uint(pmax), false, false);
      pmax = fmaxf(__uint_as_float(rr[0]), __uint_as_float(rr[1])); }
    float mn;
    if (__builtin_expect(__all((pmax - m_reg) <= AT_THR), 1)) { mn = m_reg; alpha = 1.f; }
    else { mn = fmaxf(m_reg, pmax); alpha = __builtin_amdgcn_exp2f(m_reg - mn); m_reg = mn; }
#pragma unroll
    for (int r = 0; r < 16; ++r) { p0[r] = __builtin_amdgcn_exp2f(p0[r] - mn); p1[r] = p1[r] - mn; }
}
__device__ __forceinline__ void finishSM(f32x16& p0, f32x16& p1, float alpha, float& l_reg, bf16x8& pa0, bf16x8& pa1, bf16x8& pa2, bf16x8& pa3) {
#pragma unroll
    for (int r = 0; r < 16; ++r) p1[r] = __builtin_amdgcn_exp2f(p1[r]);
    float ps = 0;
#pragma unroll
    for (int r = 0; r < 16; ++r) ps += p0[r];
#pragma unroll
    for (int r = 0; r < 16; ++r) ps += p1[r];
    { auto rr = __builtin_amdgcn_permlane32_swap(__float_as_uint(ps), __float_as_uint(ps), false, false);
      ps = __uint_as_float(rr[0]) + __uint_as_float(rr[1]); }
    l_reg = l_reg * alpha + ps;
#define FK_PK4(P, B_, OUT) do { unsigned a0 = cvtpk(P[B_+0], P[B_+1]), a1 = cvtpk(P[B_+2], P[B_+3]);                          \
        unsigned b0 = cvtpk(P[B_+4], P[B_+5]), b1 = cvtpk(P[B_+6], P[B_+7]);                                             \
        auto r0 = __builtin_amdgcn_permlane32_swap(a0, b0, false, false); auto r1 = __builtin_amdgcn_permlane32_swap(a1, b1, false, false); \
        v4u w = {r0[0], r1[0], r0[1], r1[1]}; OUT = *reinterpret_cast<bf16x8*>(&w); } while (0)
    FK_PK4(p0, 0, pa0); FK_PK4(p0, 8, pa1); FK_PK4(p1, 0, pa2); FK_PK4(p1, 8, pa3);
#undef FK_PK4
}
__device__ __forceinline__ void pv_tile(f32x16* o, int vb0, bf16x8 pa0, bf16x8 pa1, bf16x8 pa2, bf16x8 pa3) {
#define FK_TRRD(dst, off) asm volatile("ds_read_b64_tr_b16 %0, %1 offset:%2" : "=&v"(dst) : "v"(vb0), "i"(off) : "memory")
#define FK_PV_D0(d0) do { s16x4 l0, l1, l2, l3, h0, h1, h2, h3; constexpr int b_ = v_rd_off(d0, 0, 0); \
        FK_TRRD(l0, b_); FK_TRRD(h0, b_ + 2048); FK_TRRD(l1, b_ + 4096); FK_TRRD(h1, b_ + 6144); FK_TRRD(l2, b_ + 8192); FK_TRRD(h2, b_ + 10240); FK_TRRD(l3, b_ + 12288); FK_TRRD(h3, b_ + 14336); \
        asm volatile("s_waitcnt lgkmcnt(0)" ::: "memory"); FK_SBAR(); \
        o[d0] = __builtin_amdgcn_mfma_f32_32x32x16_bf16(pa0, (bf16x8){l0[0], l0[1], l0[2], l0[3], h0[0], h0[1], h0[2], h0[3]}, o[d0], 0, 0, 0);   \
        o[d0] = __builtin_amdgcn_mfma_f32_32x32x16_bf16(pa1, (bf16x8){l1[0], l1[1], l1[2], l1[3], h1[0], h1[1], h1[2], h1[3]}, o[d0], 0, 0, 0);   \
        o[d0] = __builtin_amdgcn_mfma_f32_32x32x16_bf16(pa2, (bf16x8){l2[0], l2[1], l2[2], l2[3], h2[0], h2[1], h2[2], h2[3]}, o[d0], 0, 0, 0);   \
        o[d0] = __builtin_amdgcn_mfma_f32_32x32x16_bf16(pa3, (bf16x8){l3[0], l3[1], l3[2], l3[3], h3[0], h3[1], h3[2], h3[3]}, o[d0], 0, 0, 0); } while (0)
    FK_PV_D0(0); FK_PV_D0(1); FK_PV_D0(2); FK_PV_D0(3);
#undef FK_PV_D0
#undef FK_TRRD
}
__device__ __forceinline__ int kpos_row(int b, int kp) { return kp < 16 ? FR_META + kp : (kp < TPK ? b * 4096 + kp - 16 : b * 4096 + 4095); }

__device__ __forceinline__ void attn_prompt_unit(const P& p, LAS unsigned char* lds, int b, int h, int j2) {
    const int tid = fresh_tid(), lane = tid & 63, wid = __builtin_amdgcn_readfirstlane(tid >> 6), r32 = lane & 31, hi = lane >> 5;
    const int wq = wid & 3, kh = wid >> 2;
    const int tq0 = 128 * j2 + 32 * wq, pq0 = 16 + tq0;
    LAS unsigned char* K_lds = lds; LAS unsigned char* V_lds = lds + AT_VOFF;
    LAS float* wsf = (LAS float*)(lds + AT_WS) + wid * 64; LAS float* li_l = wsf; LAS float* al_l = wsf + 32;
    bf16x8 qr[12];
    { const bf16_t* qp = p.QB + ((size_t)(b * 4096 + tq0 + r32) * 4 + h) * 192 + hi * 8;
#pragma unroll
      for (int d0 = 0; d0 < 12; ++d0) qr[d0] = *(const bf16x8*)(qp + d0 * 16); }
    float m_reg = -1e30f, l_reg = 0.f; f32x16 o[4] = {};
    const int NDT = j2 + 2;
    v4u sk[6], sv[4];
#define FK_STAGE_LOAD(dt) do { const int kp0_ = 128 * (dt); int tl_ = tid; asm volatile("" : "+v"(tl_));   \
        _Pragma("unroll") for (int i_ = 0; i_ < 6; ++i_) { const int ci = tl_ + 512 * i_, key = ci / 24, ch = ci - key * 24; \
            sk[i_] = *(const v4u*)(p.KB + ((size_t)kpos_row(b, kp0_ + key) * 4 + h) * 192 + ch * 8); } \
        _Pragma("unroll") for (int i_ = 0; i_ < 4; ++i_) { const int ci = tl_ + 512 * i_, key = ci >> 4, ch = ci & 15; \
            sv[i_] = *(const v4u*)(p.VB + ((size_t)kpos_row(b, kp0_ + key) * 4 + h) * 128 + ch * 8); } } while (0)
#define FK_STAGE_WRITE() do { int tl_ = tid; asm volatile("" : "+v"(tl_)); \
        _Pragma("unroll") for (int i_ = 0; i_ < 6; ++i_) { const int ci = tl_ + 512 * i_, key = ci / 24, ch = ci - key * 24; \
            *(LAS v4u*)(K_lds + (key >> 6) * AT_KHALF + (key & 63) * AT_KROW + ch * 16) = sk[i_]; } \
        _Pragma("unroll") for (int i_ = 0; i_ < 4; ++i_) { const int ci = tl_ + 512 * i_, key = ci >> 4, ch = ci & 15; \
            *(LAS v4u*)(V_lds + (key >> 6) * AT_VHALF + v_st(key & 63, ch * 8)) = sv[i_]; } } while (0)
    FK_STAGE_LOAD(0);
    const int vb0 = (int)(unsigned)(size_t)(V_lds + kh * AT_VHALF) + v_rd_base(lane);
    const LAS unsigned char* kbp = K_lds + kh * AT_KHALF + r32 * AT_KROW + hi * 16;
    for (int dt = 0; dt < NDT; ++dt) {
        __syncthreads();
        FK_STAGE_WRITE();
        if (dt + 1 < NDT) FK_STAGE_LOAD(dt + 1);
        __syncthreads();
        const int kb = 128 * dt + 64 * kh;
        f32x16 p0 = {}, p1 = {};
#pragma unroll
        for (int d0 = 0; d0 < 12; ++d0) {
            const bf16x8 b0 = *(const LAS bf16x8*)(kbp + 32 * d0), b1 = *(const LAS bf16x8*)(kbp + 32 * AT_KROW + 32 * d0);
            p0 = __builtin_amdgcn_mfma_f32_32x32x16_bf16(b0, qr[d0], p0, 0, 0, 0);
            p1 = __builtin_amdgcn_mfma_f32_32x32x16_bf16(b1, qr[d0], p1, 0, 0, 0); }
        if (kb + 63 > pq0) mask_tile(p0, p1, pq0 + r32 - kb - 4 * hi, 0x7fffffffu);
        float alpha; bf16x8 pa0, pa1, pa2, pa3;
        partialSM(p0, p1, m_reg, alpha);
        finishSM(p0, p1, alpha, l_reg, pa0, pa1, pa2, pa3);
        if (__any(alpha < 1.f)) { if (hi == 0) al_l[r32] = alpha; asm volatile("s_waitcnt lgkmcnt(0)" ::: "memory");
#pragma unroll
            for (int d_ = 0; d_ < 4; ++d_)
#pragma unroll
                for (int r = 0; r < 16; ++r) o[d_][r] *= al_l[crow(r, hi)]; }
        FK_SBAR();
        pv_tile(o, vb0, pa0, pa1, pa2, pa3);
    }
#undef FK_STAGE_LOAD
#undef FK_STAGE_WRITE
    __syncthreads();
    LAS float* mb = (LAS float*)lds;
    LAS float* ob = (LAS float*)(lds + 1024);
    if (kh == 1) { if (hi == 0) { mb[wq * 64 + r32] = m_reg; mb[wq * 64 + 32 + r32] = l_reg; }
#pragma unroll
        for (int d_ = 0; d_ < 4; ++d_)
#pragma unroll
            for (int r = 0; r < 16; ++r) ob[(wq * 64 + d_ * 16 + r) * 64 + lane] = o[d_][r]; }
    __syncthreads();
    if (kh == 0) {
        const float m2 = mb[wq * 64 + r32], l2 = mb[wq * 64 + 32 + r32];
        const float M = fmaxf(m_reg, m2), f1 = __builtin_amdgcn_exp2f(m_reg - M), f2 = __builtin_amdgcn_exp2f(m2 - M);
        const float l = l_reg * f1 + l2 * f2, rl = __builtin_amdgcn_rcpf(l);
        if (hi == 0) { li_l[r32] = f1 * rl; al_l[r32] = f2 * rl; }
        asm volatile("s_waitcnt lgkmcnt(0)" ::: "memory");
        bf16_t* Ow = p.CAT + (size_t)(b * 4096 + tq0) * 1024 + 512 + h * 128;
#pragma unroll
        for (int r = 0; r < 16; ++r) { const int orow = crow(r, hi); const float g1 = li_l[orow], g2 = al_l[orow];
#pragma unroll
            for (int d0 = 0; d0 < 4; ++d0) { const float v = o[d0][r] * g1 + ob[(wq * 64 + d0 * 16 + r) * 64 + lane] * g2;
                const float vn = __shfl_xor(v, 1);
                if ((r32 & 1) == 0) *(unsigned*)(Ow + (size_t)orow * 1024 + d0 * 32 + r32) = cvtpk(v, vn); } }
    }
    __syncthreads();
}
__device__ __forceinline__ void attn_meta(const P& p, LAS unsigned char* lds) {
    const int tid = fresh_tid(); LAS float* sc = (LAS float*)lds;
#pragma unroll 1
    for (int idx = tid; idx < 1024; idx += NTHREADS) { const int t = idx >> 6, h = (idx >> 4) & 3, k = idx & 15; float s = -__builtin_inff();
        if (k <= t) { s = 0.f; const bf16_t* q = p.QB + ((size_t)(FR_META + t) * 4 + h) * 192; const bf16_t* kk = p.KB + ((size_t)(FR_META + k) * 4 + h) * 192;
            for (int d = 0; d < 192; ++d) s += bf2f(q[d]) * bf2f(kk[d]); }
        sc[idx] = s; }
    __syncthreads();
#pragma unroll 1
    for (int it = tid; it < 2048; it += NTHREADS) { const int t = it >> 7, h = (it >> 5) & 3, v = (it & 31) * 4; const LAS float* s = sc + (t * 4 + h) * 16;
        float mx = s[0]; for (int k = 1; k <= t; ++k) mx = fmaxf(mx, s[k]);
        float l = 0.f; f32x4 acc = {0.f, 0.f, 0.f, 0.f};
        for (int k = 0; k <= t; ++k) { const float pk = __builtin_amdgcn_exp2f(s[k] - mx); l += pk; const bf16_t* vv = p.VB + ((size_t)(FR_META + k) * 4 + h) * 128 + v;
            acc[0] += pk * bf2f(vv[0]); acc[1] += pk * bf2f(vv[1]); acc[2] += pk * bf2f(vv[2]); acc[3] += pk * bf2f(vv[3]); }
        st_bf4(p.CAT + (size_t)(FR_META + t) * 1024 + 512 + h * 128 + v, acc * (1.0f / l)); }
    __syncthreads();
}
__device__ __forceinline__ void attn_prompt_phase(const P& p, LAS unsigned char* lds, int vcu, int G) {
    if (vcu == 0) attn_meta(p, lds);
    for (int item = vcu; item < 256; item += G) { const int bh = item >> 4, s = item & 15;
        attn_prompt_unit(p, lds, bh >> 2, bh & 3, 31 - s);
        attn_prompt_unit(p, lds, bh >> 2, bh & 3, s); }
}
}
namespace fk {
constexpr int SA_PITCH = 656;
constexpr int SA_Q = 0, SA_K = 32 * SA_PITCH, SA_V = SA_K + 64 * SA_PITCH, SA_WS = SA_V + 32768, SA_LDS = SA_WS + 2048;
constexpr int AP_STRIDE = 32 * 256 + 64;
__device__ __forceinline__ bf16x8 pack8f(f32x4 a, f32x4 b) { v4u w = {pk2(a[0], a[1]), pk2(a[2], a[3]), pk2(b[0], b[1]), pk2(b[2], b[3])}; return *reinterpret_cast<bf16x8*>(&w); }

__device__ __forceinline__ void attn_sample_unit(const P& p, LAS unsigned char* lds, int db, int half, int item) {
    const int tid = fresh_tid(), lane = tid & 63, wid = __builtin_amdgcn_readfirstlane(tid >> 6), r32 = lane & 31, hi = lane >> 5;
    const int quad = wid >> 2, cg = wid & 3;
    LAS unsigned char* Qs = lds + SA_Q; LAS unsigned char* Ks = lds + SA_K; LAS unsigned char* Vs = lds + SA_V;
    LAS float* wsf = (LAS float*)(lds + SA_WS) + wid * 64; LAS float* al_l = wsf + 32;
    { LAS float* qn = (LAS float*)Ks;
      for (int e = tid; e < 32 * 128; e += NTHREADS) { const int m = e >> 7, n = e & 127; qn[e] = bf2f(p.QB[((size_t)(FR_SAMP + db * 8 + (m >> 2)) * 4 + (m & 3)) * 192 + n]); }
      for (int e = tid; e < 32 * 64; e += NTHREADS) { const int m = e >> 6, i = e & 63;
          *(LAS bf16_t*)(Qs + m * SA_PITCH + (256 + i) * 2) = p.QB[((size_t)(FR_SAMP + db * 8 + (m >> 2)) * 4 + (m & 3)) * 192 + 128 + i]; }
      __syncthreads();
      const int r = tid & 255, hp = tid >> 8;
#pragma unroll 1
      for (int hh = 0; hh < 2; ++hh) { const int h = 2 * hp + hh; const f32x4* wr = (const f32x4*)(p.w_uk + (size_t)r * 512 + h * 128);
          float a[8];
#pragma unroll
          for (int qi = 0; qi < 8; ++qi) a[qi] = 0.f;
#pragma unroll 4
          for (int n4 = 0; n4 < 32; ++n4) { const f32x4 w = wr[n4];
#pragma unroll
              for (int qi = 0; qi < 8; ++qi) { const f32x4 q = *(const LAS f32x4*)(qn + (qi * 4 + h) * 128 + n4 * 4); a[qi] += (q[0] * w[0] + q[1] * w[1]) + (q[2] * w[2] + q[3] * w[3]); } }
#pragma unroll
          for (int qi = 0; qi < 8; ++qi) *(LAS bf16_t*)(Qs + (qi * 4 + h) * SA_PITCH + r * 2) = (bf16_t)(pk2(a[qi], a[qi]) & 0xffffu); }
      __syncthreads(); }
    const int NT = half ? 65 : 64;
    float m_reg = -1e30f, l_reg = 0.f; f32x16 o[2] = {};
    f32x4 sg[10];
#define FK_SLOAD(t) do { int tl_ = tid; asm volatile("" : "+v"(tl_)); const int key = tl_ >> 3, c8 = tl_ & 7; const float* cr; const float* kr; \
        if ((t) < 64) { const int j0 = half * 4096 + (t) * 64; const int pg = __builtin_amdgcn_readfirstlane(p.page_table[db * 64 + (j0 >> 7)]); const size_t rr = (size_t)pg * 128 + (j0 & 127) + key; \
            cr = p.cache_ckv + rr * 256; kr = p.cache_kr + rr * 64; } \
        else { const size_t rr = (size_t)db * 8 + (key & 7); cr = p.out + nv::O_CKVS + rr * 256; kr = p.out + nv::O_KRS + rr * 64; } \
        _Pragma("unroll") for (int i_ = 0; i_ < 4; ++i_) { sg[2 * i_] = *(const f32x4*)(cr + 8 * c8 + 64 * i_); sg[2 * i_ + 1] = *(const f32x4*)(cr + 8 * c8 + 64 * i_ + 4); } \
        sg[8] = *(const f32x4*)(kr + 8 * c8); sg[9] = *(const f32x4*)(kr + 8 * c8 + 4); } while (0)
#define FK_SWRITE() do { int tl_ = tid; asm volatile("" : "+v"(tl_)); const int key = tl_ >> 3, c8 = tl_ & 7; \
        _Pragma("unroll") for (int i_ = 0; i_ < 4; ++i_) { const bf16x8 v = pack8f(sg[2 * i_], sg[2 * i_ + 1]); const int col = 8 * c8 + 64 * i_; \
            *(LAS bf16x8*)(Ks + key * SA_PITCH + col * 2) = v; *(LAS bf16x8*)(Vs + (col >> 7) * 16384 + v_st(key, col & 127)) = v; } \
        *(LAS bf16x8*)(Ks + key * SA_PITCH + (256 + 8 * c8) * 2) = pack8f(sg[8], sg[9]); } while (0)
    FK_SLOAD(0);
    const LAS unsigned char* kbp = Ks + (32 * quad + r32) * SA_PITCH + hi * 16;
    const LAS unsigned char* qbp = Qs + r32 * SA_PITCH + hi * 16;
    const int vb0 = (int)(unsigned)(size_t)(Vs + (cg >> 1) * 16384) + v_rd_base(lane) + (2 * (cg & 1)) * 512 + (2 * quad) * 4096;
    for (int t = 0; t < NT; ++t) {
        __syncthreads();
        FK_SWRITE();
        if (t + 1 < NT) FK_SLOAD(t + 1);
        __syncthreads();
        f32x16 p0 = {};
#pragma unroll
        for (int d0 = 0; d0 < 20; ++d0) { const bf16x8 kf = *(const LAS bf16x8*)(kbp + 32 * d0), qf = *(const LAS bf16x8*)(qbp + 32 * d0);
            p0 = __builtin_amdgcn_mfma_f32_32x32x16_bf16(kf, qf, p0, 0, 0, 0); }
        if (t == 64) {
            const float NEG = -__builtin_inff();
#pragma unroll
            for (int r = 0; r < 16; ++r) { const int kk = 32 * quad + crow(r, hi); if (!(kk < 8 && kk <= (r32 >> 2))) p0[r] = NEG; } }
        float pmax = p0[0];
#pragma unroll
        for (int r = 1; r < 16; ++r) pmax = fmaxf(pmax, p0[r]);
        { auto rr = __builtin_amdgcn_permlane32_swap(__float_as_uint(pmax), __float_as_uint(pmax), false, false); pmax = fmaxf(__uint_as_float(rr[0]), __uint_as_float(rr[1])); }
        float mn, alpha;
        if (__builtin_expect(__all((pmax - m_reg) <= AT_THR), 1)) { mn = m_reg; alpha = 1.f; }
        else { mn = fmaxf(m_reg, pmax); alpha = __builtin_amdgcn_exp2f(m_reg - mn); m_reg = mn; }
        float ps = 0.f;
#pragma unroll
        for (int r = 0; r < 16; ++r) { p0[r] = __builtin_amdgcn_exp2f(p0[r] - mn); ps += p0[r]; }
        { auto rr = __builtin_amdgcn_permlane32_swap(__float_as_uint(ps), __float_as_uint(ps), false, false); ps = __uint_as_float(rr[0]) + __uint_as_float(rr[1]); }
        l_reg = l_reg * alpha + ps;
        bf16x8 pa0, pa1;
#define FK_PK4(P, B_, OUT) do { unsigned a0 = cvtpk(P[B_+0], P[B_+1]), a1 = cvtpk(P[B_+2], P[B_+3]); unsigned b0 = cvtpk(P[B_+4], P[B_+5]), b1 = cvtpk(P[B_+6], P[B_+7]); \
        auto r0 = __builtin_amdgcn_permlane32_swap(a0, b0, false, false); auto r1 = __builtin_amdgcn_permlane32_swap(a1, b1, false, false); \
        v4u w = {r0[0], r1[0], r0[1], r1[1]}; OUT = *reinterpret_cast<bf16x8*>(&w); } while (0)
        FK_PK4(p0, 0, pa0); FK_PK4(p0, 8, pa1);
#undef FK_PK4
        if (__any(alpha < 1.f)) { if (hi == 0) al_l[r32] = alpha; asm volatile("s_waitcnt lgkmcnt(0)" ::: "memory");
#pragma unroll
            for (int d_ = 0; d_ < 2; ++d_)
#pragma unroll
                for (int r = 0; r < 16; ++r) o[d_][r] *= al_l[crow(r, hi)]; }
        FK_SBAR();
#define FK_TRRD(dst, off) asm volatile("ds_read_b64_tr_b16 %0, %1 offset:%2" : "=&v"(dst) : "v"(vb0), "i"(off) : "memory")
#define FK_PV2(d) do { s16x4 l0, l1, h0, h1; FK_TRRD(l0, (d) * 512); FK_TRRD(h0, (d) * 512 + 2048); FK_TRRD(l1, (d) * 512 + 4096); FK_TRRD(h1, (d) * 512 + 6144); \
        asm volatile("s_waitcnt lgkmcnt(0)" ::: "memory"); FK_SBAR(); \
        o[d] = __builtin_amdgcn_mfma_f32_32x32x16_bf16(pa0, (bf16x8){l0[0], l0[1], l0[2], l0[3], h0[0], h0[1], h0[2], h0[3]}, o[d], 0, 0, 0); \
        o[d] = __builtin_amdgcn_mfma_f32_32x32x16_bf16(pa1, (bf16x8){l1[0], l1[1], l1[2], l1[3], h1[0], h1[1], h1[2], h1[3]}, o[d], 0, 0, 0); } while (0)
        FK_PV2(0); FK_PV2(1);
#undef FK_PV2
#undef FK_TRRD
    }
#undef FK_SLOAD
#undef FK_SWRITE
    __syncthreads();
    LAS float* mb = (LAS float*)(lds + SA_K);
    LAS float* ob = (LAS float*)(lds + SA_K + 1024);
    if (quad == 1) { if (hi == 0) { mb[cg * 64 + r32] = m_reg; mb[cg * 64 + 32 + r32] = l_reg; }
#pragma unroll
        for (int d_ = 0; d_ < 2; ++d_)
#pragma unroll
            for (int r = 0; r < 16; ++r) ob[(cg * 32 + d_ * 16 + r) * 64 + lane] = o[d_][r]; }
    __syncthreads();
    if (quad == 0) {
        const float m2 = mb[cg * 64 + r32], l2 = mb[cg * 64 + 32 + r32];
        const float M = fmaxf(m_reg, m2), f1 = __builtin_amdgcn_exp2f(m_reg - M), f2 = __builtin_amdgcn_exp2f(m2 - M);
        const float l = l_reg * f1 + l2 * f2;
        if (hi == 0) { wsf[r32] = f1; al_l[r32] = f2; }
        asm volatile("s_waitcnt lgkmcnt(0)" ::: "memory");
        float* ap = p.APART + (size_t)item * AP_STRIDE;
        if (cg == 0 && hi == 0) { ap[32 * 256 + r32] = M; ap[32 * 256 + 32 + r32] = l; }
#pragma unroll
        for (int r = 0; r < 16; ++r) { const int orow = crow(r, hi); const float g1 = wsf[orow], g2 = al_l[orow];
#pragma unroll
            for (int d_ = 0; d_ < 2; ++d_) ap[orow * 256 + 64 * cg + 32 * d_ + r32] = o[d_][r] * g1 + ob[(cg * 32 + d_ * 16 + r) * 64 + lane] * g2; }
    }
    __syncthreads();
}
__device__ __forceinline__ void attn_sample_phase(const P& p, LAS unsigned char* lds, int vcu, int G) {
    for (int item = vcu; item < 256; item += G) attn_sample_unit(p, lds, item >> 1, item & 1, item);
}
__device__ __forceinline__ void attn_sample_combine(const P& p, LAS unsigned char* lds, int vcu, int G) {
    const int tid = fresh_tid(); LAS float* ol = (LAS float*)lds;
    for (int db = vcu; db < 128; db += G) {
        const float* a0 = p.APART + (size_t)(2 * db) * AP_STRIDE; const float* a1 = a0 + AP_STRIDE;
        __syncthreads();
        for (int e = tid; e < 32 * 256; e += NTHREADS) { const int m = e >> 8;
            const float m0 = a0[8192 + m], m1 = a1[8192 + m], l0 = a0[8192 + 32 + m], l1 = a1[8192 + 32 + m];
            const float M = fmaxf(m0, m1), f0 = __builtin_amdgcn_exp2f(m0 - M), f1 = __builtin_amdgcn_exp2f(m1 - M);
            ol[e] = (a0[e] * f0 + a1[e] * f1) / (l0 * f0 + l1 * f1); }
        __syncthreads();
        const int h = tid >> 7, v = tid & 127; float acc[8];
#pragma unroll
        for (int qi = 0; qi < 8; ++qi) acc[qi] = 0.f;
#pragma unroll 4
        for (int r = 0; r < 256; ++r) { const float w = p.w_uv[(size_t)r * 512 + h * 128 + v];
#pragma unroll
            for (int qi = 0; qi < 8; ++qi) acc[qi] += ol[(qi * 4 + h) * 256 + r] * w; }
#pragma unroll
        for (int qi = 0; qi < 8; ++qi) p.CAT[(size_t)(FR_SAMP + db * 8 + qi) * 1024 + 512 + h * 128 + v] = (bf16_t)(pk2(acc[qi], acc[qi]) & 0xffffu);
    }
    __syncthreads();
}
}
namespace fk {
__device__ __forceinline__ float gelu_tanh(float x) { const float u = 0.7978845608028654f * (x + 0.044715f * x * x * x); const float e = __builtin_amdgcn_exp2f(2.885390081777927f * u);
    return 0.5f * x * (2.0f - 2.0f * __builtin_amdgcn_rcpf(e + 1.0f)); }
__device__ __forceinline__ void s5_slow_item(const P& p, LAS float* part  , int seq, int g) {
    const int lane = fresh_tid() & 63, pp = lane; const bool prompt = seq < 1; const int db = seq - 1;
    const int gp = g * 64 + pp;
    const float ar = p.abar_re[gp], ai = p.abar_im[gp];
    float br[16], bi[16], cr[16], ci[16];
#pragma unroll
    for (int j = 0; j < 16; ++j) { br[j] = p.bbar_re[gp * 16 + j]; bi[j] = p.bbar_im[gp * 16 + j]; cr[j] = p.c_re[(g * 16 + j) * 64 + pp]; ci[j] = p.c_im[(g * 16 + j) * 64 + pp]; }
    float hr = prompt ? 0.f : p.st_re[(size_t)db * 2048 + gp], hi_ = prompt ? 0.f : p.st_im[(size_t)db * 2048 + gp];
    const float dk = p.s5_d[g * 16 + (lane & 15)];
    const int T = prompt ? 16 : 8;
#pragma unroll 1
    for (int t = 0; t < T; ++t) {
        const int fr = prompt ? FR_META + t : FR_SAMP + db * 8 + t;
        const v4u u0 = *(const v4u*)(p.U + (size_t)fr * 512 + g * 16), u1 = *(const v4u*)(p.U + (size_t)fr * 512 + g * 16 + 8);
        float u[16];
#pragma unroll
        for (int k = 0; k < 4; ++k) { u[2 * k] = __uint_as_float(u0[k] << 16); u[2 * k + 1] = __uint_as_float(u0[k] & 0xffff0000u); u[8 + 2 * k] = __uint_as_float(u1[k] << 16); u[8 + 2 * k + 1] = __uint_as_float(u1[k] & 0xffff0000u); }
        float bur = 0.f, bui = 0.f;
#pragma unroll
        for (int j = 0; j < 16; ++j) { bur += br[j] * u[j]; bui += bi[j] * u[j]; }
        const float nr = ar * hr - ai * hi_ + bur, ni = ar * hi_ + ai * hr + bui; hr = nr; hi_ = ni;
#pragma unroll
        for (int j = 0; j < 16; ++j) part[pp * 17 + j] = cr[j] * hr - ci[j] * hi_;
        asm volatile("s_waitcnt lgkmcnt(0)" ::: "memory");
        float s = 0.f; const int j = lane & 15, q4 = lane >> 4;
#pragma unroll
        for (int k = 0; k < 16; ++k) s += part[(q4 * 16 + k) * 17 + j];
        s += __shfl_xor(s, 16); s += __shfl_xor(s, 32);
        float uj = u[0];
#pragma unroll
        for (int k = 1; k < 16; ++k) uj = (j == k) ? u[k] : uj;
        const float y = gelu_tanh(s + dk * uj);
        if (lane < 16) p.YS[(size_t)fr * 512 + g * 16 + j] = (bf16_t)(pk2(y, y) & 0xffffu);
        asm volatile("s_waitcnt lgkmcnt(0)" ::: "memory");
    }
    if (prompt) { p.HM[g * 128 + pp] = hr; p.HM[g * 128 + 64 + pp] = hi_; }
    else { p.out[nv::O_SRES + (size_t)db * 2048 + gp] = hr; p.out[nv::O_SIMS + (size_t)db * 2048 + gp] = hi_; }
}
__device__ __forceinline__ void s5_slow_phase(const P& p, LAS unsigned char* lds, int vcu, int G) {
    const int wave = fresh_tid() >> 6; LAS float* part = (LAS float*)lds + wave * (64 * 17);
    for (int it = vcu + G * wave; it < 129 * 32; it += G * NWAVES) s5_slow_item(p, part, it >> 5, it & 31);
    const int gid = vcu * NTHREADS + fresh_tid(), nth = G * NTHREADS;
    for (int i = gid; i < 240 * 64; i += nth) *(v4u*)(p.YS + (size_t)(FR_META + 16) * 512 + (size_t)i * 8) = (v4u){0u, 0u, 0u, 0u};
}
}
namespace fk {
__device__ __forceinline__ void s5_tables_a(const P& p, int vcu, int G) {
    const int tid = fresh_tid(), lane = tid & 63, wave = tid >> 6;
    for (int it = vcu + G * wave; it < 32 * 33; it += G * NWAVES) { const int g = it / 33, k = it - g * 33, gp = g * 64 + lane;
        const double dt = exp((double)p.log_dt[g]), ar = p.a_re[gp], ai = p.a_im[gp];
        const double mag = exp((double)k * dt * ar), ang = (double)k * dt * ai; const float pr = (float)(mag * cos(ang)), pi_ = (float)(mag * sin(ang));
        p.APOW[((size_t)gp * 33 + k) * 2] = pr; p.APOW[((size_t)gp * 33 + k) * 2 + 1] = pi_;
        if (k < 32) {
            const double mg1 = exp(dt * ar), c1r = mg1 * cos(dt * ai), c1i = mg1 * sin(dt * ai), nr = c1r - 1.0, ni = c1i, den = ar * ar + ai * ai;
            const float fr_ = (float)((nr * ar + ni * ai) / den), fi_ = (float)((ni * ar - nr * ai) / den);
            float xr[16], xi[16];
#pragma unroll
            for (int j = 0; j < 16; ++j) { const float br = p.b_re[gp * 16 + j], bi = p.b_im[gp * 16 + j]; const float bbr = fr_ * br - fi_ * bi, bbi = fr_ * bi + fi_ * br;
                xr[j] = pr * bbr - pi_ * bbi; xi[j] = pr * bbi + pi_ * bbr; }
#pragma unroll 1
            for (int hh = 0; hh < 16; ++hh) { const float cr = p.c_re[(g * 16 + hh) * 64 + lane], ci = p.c_im[(g * 16 + hh) * 64 + lane]; float mine = 0.f;
#pragma unroll
                for (int j = 0; j < 16; ++j) { const float s = wsum(cr * xr[j] - ci * xi[j]); mine = (lane == j) ? s : mine; }
                if (lane < 16) p.KG[(((size_t)g * 32 + k) * 16 + hh) * 16 + lane] = mine; }
        }
    }
}
__device__ __forceinline__ void s5_tables_b(const P& p, int vcu, int G) {
    const int gid = vcu * NTHREADS + fresh_tid(), nth = G * NTHREADS;
    for (int i = gid; i < 32 * 256 * 80; i += nth) { const int k0 = (i % 80) * 8, n = (i / 80) & 255, g = i / (80 * 256); float v[8];
#pragma unroll
        for (int e = 0; e < 8; ++e) v[e] = 0.f;
        if (n < 128 && k0 < 512) { const int ri = n >> 6, pp = n & 63, s = k0 >> 4, j0 = k0 & 15, gp = g * 64 + pp;
            const float pr = p.APOW[((size_t)gp * 33 + 31 - s) * 2], pi_ = p.APOW[((size_t)gp * 33 + 31 - s) * 2 + 1];
#pragma unroll
            for (int e = 0; e < 8; ++e) { const float br = p.bbar_re[gp * 16 + j0 + e], bi = p.bbar_im[gp * 16 + j0 + e]; v[e] = ri == 0 ? pr * br - pi_ * bi : pr * bi + pi_ * br; } }
        *(v4u*)(p.Bt_S + ((size_t)(g * 256 + n)) * 640 + k0) = (v4u){pk2(v[0], v[1]), pk2(v[2], v[3]), pk2(v[4], v[5]), pk2(v[6], v[7])};
    }
    for (int i = gid; i < 32 * 512 * 80; i += nth) { const int k0 = (i % 80) * 8, n = (i / 80) & 511, g = i / (80 * 512), t = n >> 4, hh = n & 15; float v[8];
#pragma unroll
        for (int e = 0; e < 8; ++e) v[e] = 0.f;
        if (k0 < 512) { const int s = k0 >> 4, j0 = k0 & 15;
            if (s <= t) { const float* kg = p.KG + (((size_t)g * 32 + (t - s)) * 16 + hh) * 16 + j0;
#pragma unroll
                for (int e = 0; e < 8; ++e) v[e] = kg[e]; } }
        else { const int kk = k0 - 512, ri = kk >> 6, p0 = kk & 63;
#pragma unroll
            for (int e = 0; e < 8; ++e) { const int gp = g * 64 + p0 + e; const float pr = p.APOW[((size_t)gp * 33 + t + 1) * 2], pi_ = p.APOW[((size_t)gp * 33 + t + 1) * 2 + 1];
                const float cr = p.c_re[(g * 16 + hh) * 64 + p0 + e], ci = p.c_im[(g * 16 + hh) * 64 + p0 + e];
                v[e] = ri == 0 ? cr * pr - ci * pi_ : -(cr * pi_ + ci * pr); } }
        *(v4u*)(p.Bt_Y + ((size_t)(g * 512 + n)) * 640 + k0) = (v4u){pk2(v[0], v[1]), pk2(v[2], v[3]), pk2(v[4], v[5]), pk2(v[6], v[7])};
    }
    for (int i = gid; i < 32 * 512 * 16; i += nth) *(v4u*)(p.UG2 + (size_t)(i >> 4) * 640 + 512 + (i & 15) * 8) = (v4u){0u, 0u, 0u, 0u};
}
struct S5OrderS { int G, c; __device__ __forceinline__ bool next(int i, Unit& u) const { const int L = i * G + c; if (L >= 64) return false; u.pm = L; u.pn = L >> 1; return true; }
    __device__ __forceinline__ void a_ready(const Unit&) const {} __device__ __forceinline__ void done(const Unit&) const {} };
struct S5OrderY { int G, c; __device__ __forceinline__ bool next(int i, Unit& u) const { const int L = i * G + c; if (L >= 128) return false; const int g = L >> 2; u.pm = 2 * g + ((L >> 1) & 1); u.pn = 2 * g + (L & 1); return true; }
    __device__ __forceinline__ void a_ready(const Unit&) const {} __device__ __forceinline__ void done(const Unit&) const {} };
struct EpiS5S {
    static constexpr bool PERM = false, AFTER_DRAIN = false;
    P p;
    __device__ __forceinline__ void operator()(const f32x4 (&acc)[2][2][4][2], const Unit& u, int wr, int wc, int fr, int fq) const {
        { const int t_ = fresh_tid(); fr = t_ & 15; fq = (t_ >> 4) & 3; }
#pragma unroll
        for (int ai = 0; ai < 2; ++ai)
#pragma unroll
            for (int m = 0; m < 4; ++m) { const int row = u.pm * 256 + ai * 128 + wr * 64 + m * 16 + fr;
#pragma unroll
                for (int n = 0; n < 2; ++n) *(f32x4*)(p.SC + (size_t)row * 128 + wc * 32 + n * 16 + 4 * fq) = acc[ai][0][m][n]; }
    }
};
struct EpiS5Y {
    static constexpr bool PERM = false, AFTER_DRAIN = false;
    P p;
    __device__ __forceinline__ void operator()(const f32x4 (&acc)[2][2][4][2], const Unit& u, int wr, int wc, int fr, int fq) const {
        { const int t_ = fresh_tid(); fr = t_ & 15; fq = (t_ >> 4) & 3; }
        const int g = u.pn >> 1, nl = u.pn & 1;
#pragma unroll
        for (int ai = 0; ai < 2; ++ai)
#pragma unroll
            for (int m = 0; m < 4; ++m) { const int crow_ = (u.pm & 1) * 256 + ai * 128 + wr * 64 + m * 16 + fr;
#pragma unroll
                for (int bj = 0; bj < 2; ++bj)
#pragma unroll
                    for (int n = 0; n < 2; ++n) { const int nn = nl * 256 + bj * 128 + wc * 32 + n * 16 + 4 * fq, t = nn >> 4, hh = nn & 15;
                        const int tok = crow_ * 32 + t;
                        const u32x2 ub = *(const u32x2*)(p.U + (size_t)tok * 512 + g * 16 + hh); const f32x4 d = *(const f32x4*)(p.s5_d + g * 16 + hh); const f32x4 a = acc[ai][bj][m][n];
                        f32x4 y; y[0] = gelu_tanh(a[0] + d[0] * __uint_as_float(ub.x << 16)); y[1] = gelu_tanh(a[1] + d[1] * __uint_as_float(ub.x & 0xffff0000u));
                        y[2] = gelu_tanh(a[2] + d[2] * __uint_as_float(ub.y << 16)); y[3] = gelu_tanh(a[3] + d[3] * __uint_as_float(ub.y & 0xffff0000u));
                        st_bf4(p.YS + (size_t)tok * 512 + g * 16 + hh, y); }
                asm volatile("" ::: "memory"); }
    }
};
__device__ __forceinline__ void s5_carry_phase(const P& p, int vcu, int G) {
    const int tid = fresh_tid(), lane = tid & 63, wave = tid >> 6;
    for (int it = vcu + G * wave; it < 128; it += G * NWAVES) { const int b = it >> 5, g = it & 31, gp = g * 64 + lane;
        const float ar = p.APOW[((size_t)gp * 33 + 32) * 2], ai = p.APOW[((size_t)gp * 33 + 32) * 2 + 1];
        float hr = p.HM[g * 128 + lane], hi_ = p.HM[g * 128 + 64 + lane];
        const size_t row0 = (size_t)g * 512 + b * 128;
#pragma unroll 1
        for (int c0 = 0; c0 < 128; c0 += 8) { float sr[8], si[8];
#pragma unroll
            for (int k = 0; k < 8; ++k) { sr[k] = p.SC[(row0 + c0 + k) * 128 + lane]; si[k] = p.SC[(row0 + c0 + k) * 128 + 64 + lane]; }
#pragma unroll
            for (int k = 0; k < 8; ++k) { bf16_t* hp = p.UG2 + (row0 + c0 + k) * 640 + 512;
                hp[lane] = (bf16_t)(pk2(hr, hr) & 0xffffu); hp[64 + lane] = (bf16_t)(pk2(hi_, hi_) & 0xffffu);
                const float nr = ar * hr - ai * hi_ + sr[k], ni = ar * hi_ + ai * hr + si[k]; hr = nr; hi_ = ni; } }
        p.out[nv::O_SREP + (size_t)b * 2048 + gp] = hr; p.out[nv::O_SIMP + (size_t)b * 2048 + gp] = hi_;
    }
}
}
namespace fk {
constexpr int LDS_BYTES = 147456, LDSCTL_OFF = 131072, MISC_OFF = LDSCTL_OFF + 320;
constexpr int CW_BAR = 4096;
extern __shared__ __attribute__((aligned(16))) unsigned char lds_dyn[];
#define FK_GEMM(EPI, A_, B_, M_, N_, K_) do { int k_ = (K_); asm volatile("" : "+s"(k_));     \
        pg8::Gemm g_{A_, B_, M_, N_, k_}; pg8::StaticOrder S_; S_.init(M_, N_, G, (int)blockIdx.x); EPI E_{p}; \
        pg8::gemm_phase<EPI, pg8::StaticOrder, true, true>(lds, g_, S_, E_); } while (0)
__global__ void __launch_bounds__(512, 2) mk_fwd(P p) {
    LAS unsigned char* lds = (LAS unsigned char*)lds_dyn;
    const int tid = threadIdx.x, G = gridDim.x; const int bx = blockIdx.x; const int vcu = (G % 8 == 0) ? (bx % 8) * (G / 8) + bx / 8 : bx;
    for (int u = tid; u < (LDS_BYTES - LDSCTL_OFF) / 4; u += NTHREADS) ((LAS unsigned*)(lds + LDSCTL_OFF))[u] = 0u;
    __syncthreads();
    XcdBarrier bar = xcd_barrier_post((unsigned*)p.ctl + CW_BAR, (volatile LAS unsigned*)(lds + MISC_OFF) + 8);
    prologue(p, lds, vcu, G);
    s5_tables_a(p, vcu, G);
    xcd_barrier(bar);
    FK_GEMM(EpiIn, p.XN, p.Bt_in, MP, 1280, 1024);
    s5_tables_b(p, vcu, G);
    xcd_barrier(bar);
    FK_GEMM(EpiQ, p.CQ, p.Bt_uq, MP, 768, 384);
    FK_GEMM(EpiKV, p.CKVB, p.Bt_kv, 65 * 256, 1024, 256);
    { int k_ = 640; asm volatile("" : "+s"(k_)); pg8::Gemm g_{p.UG2, p.Bt_S, 32 * 512, 256, k_}; S5OrderS S_{G, (int)blockIdx.x}; EpiS5S E_{p};
      pg8::gemm_phase<EpiS5S, S5OrderS, true, true>(lds, g_, S_, E_); }
    ckv_fixup(p, vcu, G);
    __syncthreads();
    s5_slow_phase(p, lds, vcu, G);
    xcd_barrier(bar);
    s5_carry_phase(p, vcu, G);
    attn_prompt_phase(p, lds, vcu, G);
    attn_sample_phase(p, lds, vcu, G);
    xcd_barrier(bar);
    attn_sample_combine(p, lds, vcu, G);
    { int k_ = 640; asm volatile("" : "+s"(k_)); pg8::Gemm g_{p.UG2, p.Bt_Y, 32 * 512, 512, k_}; S5OrderY S_{G, (int)blockIdx.x}; EpiS5Y E_{p};
      pg8::gemm_phase<EpiS5Y, S5OrderY, true, true>(lds, g_, S_, E_); }
    xcd_barrier(bar);
    FK_GEMM(EpiGLU, p.YS, p.Bt_glu, MP, 512, 512);
    xcd_barrier(bar);
    FK_GEMM(EpiOut, p.CAT, p.Bt_out, MP, 1024, 1024);
    xcd_barrier(bar);
    FK_GEMM(EpiGU1, p.X1B, p.Bt_gu, MP, 5632, 1024);
    xcd_barrier(bar);
    conv_pass(p, vcu, G);
    xcd_barrier(bar);
    FK_GEMM(EpiDown1, p.H, p.Bt_down, MP, 1024, 2816);
    xcd_barrier(bar);
    final_pass(p, vcu, G);
}
inline void launch(void* const* d_in, float* out, void* d_ws, hipStream_t stream) {
    static int grid = 0;
    if (grid == 0) {
        int dev = 0, cus = 0;
        if (hipGetDevice(&dev) != hipSuccess || hipDeviceGetAttribute(&cus, hipDeviceAttributeMultiprocessorCount, dev) != hipSuccess) { grid = -1; return; }
        if (hipFuncSetAttribute((const void*)mk_fwd, hipFuncAttributeMaxDynamicSharedMemorySize, LDS_BYTES) != hipSuccess) { grid = -1; return; }
        grid = cus;
    }
    if (grid < 0) return;
    P p{}; fill_inputs(p, d_in, out); carve(p, (char*)d_ws);
    (void)hipMemsetAsync(p.ctl, 0, (size_t)1 << 20, stream);
    hipLaunchKernelGGL(mk_fwd, dim3(grid), dim3(NTHREADS), LDS_BYTES, stream, p);
}
}
extern "C" void kernel_launch(void* const* d_in, const int* in_sizes, int n_in,
                              void* d_out, int out_size, void* d_ws, size_t ws_size,
                              hipStream_t stream) {
    fk::launch(d_in, (float*)d_out, d_ws, stream);
}
```
